# Optimizing an MI355X kernel written in HIP

```python
import math
import jax
import jax.numpy as jnp
from jax import lax
import numpy as np

D_MODEL = 2048
BATCH = 4
SEQ = 4096
DEPTH = 2

CTX_LEN = 256
GRID_W = 64
EPS = 1e-6
N_MOD = 6

NA_HEADS = 8
NA_HEAD_DIM = 128
NA_WIN_H = 8
NA_WIN_W = 16
NA_QBLK = NA_WIN_W
NA_KBLK = 2 * NA_WIN_W

ML_HEADS = 4
ML_QK_DIM = 128
ML_V_DIM = 256
ML_CHUNK = 64

HG_HEADS = 8
HG_K_DIM = 128
HG_V_DIM = 128
HG_CHUNK = 32

SSD_HEADS = 16
SSD_HEAD_DIM = 64
SSD_GROUPS = 2
SSD_STATE = 128
SSD_CONV = 5
SSD_CHUNK = 64

FFN_MULT = 256
FFN_HIDDEN = ((8 * D_MODEL + 3 * FFN_MULT - 1) // (3 * FFN_MULT)) * FFN_MULT

NA_W = NA_HEADS * NA_HEAD_DIM
ML_QK_W = ML_HEADS * ML_QK_DIM
ML_W = ML_HEADS * ML_V_DIM
HG_K_W = HG_HEADS * HG_K_DIM
HG_W = HG_HEADS * HG_V_DIM
SSD_W = SSD_HEADS * SSD_HEAD_DIM
SSD_BC_W = SSD_GROUPS * SSD_STATE
SSD_XBC = SSD_W + 2 * SSD_BC_W

EVEN_SPLIT = (NA_W, NA_W, NA_W, ML_QK_W, ML_QK_W, ML_W, ML_W, 4 * ML_HEADS)
ODD_SPLIT = (HG_K_W, HG_K_W, HG_K_W, HG_W, HG_W, SSD_W, SSD_XBC, 2 * SSD_HEADS)
EVEN_IN = sum(EVEN_SPLIT)
ODD_IN = sum(ODD_SPLIT)
EVEN_MIX = NA_W + ML_W
ODD_MIX = HG_W + SSD_W

kernel_name = 'hybrid_natten_mlstm_hgrn2_ssd_flow_block'


def rms_norm(x):
    xf = x.astype(jnp.float32)
    y = xf * lax.rsqrt(jnp.mean(xf * xf, axis=-1, keepdims=True) + EPS)
    return y.astype(x.dtype)


def modulate(x, shift, scale):
    return rms_norm(x) * (1 + scale) + shift


def modulation(cvec, mod_w, mod_b):
    return jnp.split(jax.nn.silu(cvec) @ mod_w + mod_b, N_MOD, axis=-1)


def split_cols(p, sizes):
    return jnp.split(p, [int(v) for v in np.cumsum(sizes)[:-1]], axis=-1)


def heads(t, n):
    b, T, _ = t.shape
    return t.reshape(b, T, n, -1).transpose(0, 2, 1, 3)


def merge_heads(t):
    b, n, T, d = t.shape
    return t.transpose(0, 2, 1, 3).reshape(b, T, n * d)


def swiglu(h, w1, w3, w2):
    return (jax.nn.silu(h @ w1) * (h @ w3)) @ w2


def centred_conv(x, w, b):
    k, ch = w.shape
    y = lax.conv_general_dilated(x, w[:, None, :], window_strides=(1,), padding=[(k // 2, k // 2)],
                                 dimension_numbers=('NWC', 'WIO', 'NWC'), feature_group_count=ch)
    return y + b


def chunked_scan(step, xs, state0, chunk):
    T = xs[0].shape[2]
    nc = T // chunk

    def to_chunks(a):
        a = a.reshape(a.shape[:2] + (nc, chunk) + a.shape[3:])
        return jnp.moveaxis(a, 2, 0)

    state, ys = lax.scan(step, state0, tuple(to_chunks(a) for a in xs))
    ys = jnp.moveaxis(ys, 0, 2)
    return ys.reshape(ys.shape[:2] + (T,) + ys.shape[4:]), state


def bidirectional(step, chunk, state0, ctx_fwd, lat_fwd, ctx_bwd, lat_bwd):
    yc_f, st_f = chunked_scan(step, ctx_fwd, state0, chunk)
    yl_f, _ = chunked_scan(step, lat_fwd, st_f, chunk)
    flip = lambda xs: tuple(jnp.flip(a, 2) for a in xs)
    yc_b, st_b = chunked_scan(step, flip(ctx_bwd), state0, chunk)
    yl_b, _ = chunked_scan(step, flip(lat_bwd), st_b, chunk)
    return yc_f + jnp.flip(yc_b, 2), yl_f + jnp.flip(yl_b, 2)


def mlstm_chunk(carry, xs):
    C, nrm, m = carry
    q, k, v, li, lf = xs
    L = q.shape[2]
    causal = jnp.tril(jnp.ones((L, L), bool))
    bcum = jnp.cumsum(lf, axis=-1)
    dlog = jnp.where(causal, bcum[..., :, None] - bcum[..., None, :] + li[..., None, :], -jnp.inf)
    inter = bcum + m[..., None]
    m_t = jnp.maximum(inter, jnp.max(dlog, axis=-1))
    w_inter = jnp.exp(inter - m_t)
    s = jnp.einsum('bhtk,bhsk->bhts', q, k) * jnp.exp(dlog - m_t[..., None])
    num = w_inter[..., None] * jnp.einsum('bhvk,bhtk->bhtv', C, q) + jnp.einsum('bhts,bhsv->bhtv', s, v)
    den = w_inter * jnp.einsum('bhk,bhtk->bht', nrm, q) + jnp.sum(s, axis=-1)
    h = num / jnp.maximum(jnp.abs(den), jnp.exp(-m_t))[..., None]
    b_last = bcum[..., -1]
    g = b_last[..., None] - bcum + li
    m_new = jnp.maximum(b_last + m, jnp.max(g, axis=-1))
    a = jnp.exp(b_last + m - m_new)
    w = jnp.exp(g - m_new[..., None])
    C_new = a[..., None, None] * C + jnp.einsum('bhs,bhsv,bhsk->bhvk', w, v, k)
    n_new = a[..., None] * nrm + jnp.einsum('bhs,bhsk->bhk', w, k)
    return (C_new, n_new, m_new), h


def hgrn_chunk(S, xs):
    q, k, lg, v = xs
    L = q.shape[2]
    causal = jnp.tril(jnp.ones((L, L), bool))
    G = jnp.cumsum(lg, axis=2)
    diff = G[:, :, :, None, :] - G[:, :, None, :, :]
    dec = jnp.exp(jnp.where(causal[:, :, None], diff, -jnp.inf))
    A = jnp.einsum('bhtk,bhsk,bhtsk->bhts', q, k, dec)
    o = jnp.einsum('bhts,bhsv->bhtv', A, v) + jnp.einsum('bhtk,bhkv->bhtv', q * jnp.exp(G), S)
    GL = G[:, :, -1:, :]
    S_new = jnp.exp(GL[:, :, 0])[..., None] * S + jnp.einsum('bhsk,bhsv->bhkv', k * jnp.exp(GL - G), v)
    return S_new, o


def ssd_chunk(S, xs):
    x, dt, a, Bm, Cm = xs
    nh = x.shape[1]
    L = x.shape[2]
    hpg = nh // Bm.shape[1]
    causal = jnp.tril(jnp.ones((L, L), bool))
    Bh = jnp.repeat(Bm, hpg, axis=1)
    Ch = jnp.repeat(Cm, hpg, axis=1)
    acum = jnp.cumsum(a, axis=-1)
    decay = jnp.exp(jnp.where(causal, acum[..., :, None] - acum[..., None, :], -jnp.inf))
    cb = jnp.einsum('bhtn,bhsn->bhts', Ch, Bh) * decay * dt[..., None, :]
    y = jnp.einsum('bhts,bhsp->bhtp', cb, x) + jnp.einsum('bhtn,bhpn->bhtp', Ch * jnp.exp(acum)[..., None], S)
    w = jnp.exp(acum[..., -1:] - acum) * dt
    S_new = jnp.exp(acum[..., -1])[..., None, None] * S + jnp.einsum('bhsn,bhs,bhsp->bhpn', Bh, w, x)
    return S_new, y


def neighbourhood_attention(q, k, v, qc, kc, vc, rpb):
    b, h, n, dh = q.shape
    rows = n // GRID_W
    win_h = min(NA_WIN_H, rows)
    ncb = GRID_W // NA_QBLK
    scale = dh ** -0.5
    f32 = jnp.float32
    qcol = np.arange(GRID_W).reshape(ncb, NA_QBLK)
    kstart = np.clip(np.arange(ncb) * NA_QBLK - NA_WIN_W // 2, 0, GRID_W - NA_KBLK)
    kcol = kstart[:, None] + np.arange(NA_KBLK)
    wstart = np.clip(qcol - NA_WIN_W // 2, 0, GRID_W - NA_WIN_W)
    col_ok = (kcol[:, None, :] >= wstart[..., None]) & (kcol[:, None, :] < wstart[..., None] + NA_WIN_W)
    mask = jnp.asarray(np.broadcast_to(col_ok[:, :, None, :], (ncb, NA_QBLK, win_h, NA_KBLK))
                       .reshape(ncb, NA_QBLK, win_h * NA_KBLK))
    dcol = np.clip(kcol[:, None, :] - qcol[..., None], -(NA_WIN_W - 1), NA_WIN_W - 1) + NA_WIN_W - 1
    qg = q.reshape(b, h, rows, ncb, NA_QBLK, dh)
    kg = k.reshape(b, h, rows, GRID_W, dh)
    vg = v.reshape(b, h, rows, GRID_W, dh)
    rpb32 = rpb.astype(f32)

    def row_block(r):
        r0 = jnp.clip(r - win_h // 2, 0, rows - win_h)
        qr = lax.dynamic_index_in_dim(qg, r, axis=2, keepdims=False)

        def gather_band(t):
            band = lax.dynamic_slice_in_dim(t, r0, win_h, axis=2)[:, :, :, kcol]
            return band.transpose(0, 1, 3, 2, 4, 5).reshape(b, h, ncb, win_h * NA_KBLK, dh)

        kb = gather_band(kg)
        vb = gather_band(vg)
        drow = r0 + jnp.arange(win_h) - r + NA_WIN_H - 1
        bias = rpb32[:, drow][:, :, dcol]
        bias = bias.transpose(0, 2, 3, 1, 4).reshape(h, ncb, NA_QBLK, win_h * NA_KBLK)
        s_loc = jnp.einsum('bhjqd,bhjkd->bhjqk', qr, kb).astype(f32) * scale + bias[None]
        s_loc = jnp.where(mask, s_loc, -jnp.inf)
        s_ctx = jnp.einsum('bhjqd,bhcd->bhjqc', qr, kc).astype(f32) * scale
        p = jax.nn.softmax(jnp.concatenate([s_loc, s_ctx], axis=-1), axis=-1).astype(v.dtype)
        nk = s_loc.shape[-1]
        return (jnp.einsum('bhjqk,bhjkd->bhjqd', p[..., :nk], vb)
                + jnp.einsum('bhjqc,bhcd->bhjqd', p[..., nk:], vc))

    out = lax.map(row_block, jnp.arange(rows))
    out_lat = out.transpose(1, 2, 0, 3, 4, 5).reshape(b, h, n, dh)
    s_c = jnp.einsum('bhqd,bhkd->bhqk', qc, kc).astype(f32) * scale
    out_ctx = jnp.einsum('bhqk,bhkd->bhqd', jax.nn.softmax(s_c, axis=-1).astype(vc.dtype), vc)
    return out_lat, out_ctx


def mixer_na_mlstm(h_lat, h_ctx, w_in, q_gain, k_gain, rpb, gate_bias, ml_gain):
    dtype = h_lat.dtype
    f32 = jnp.float32
    lat = split_cols(h_lat @ w_in, EVEN_SPLIT)
    ctx = split_cols(h_ctx @ w_in, EVEN_SPLIT)
    qkn = lambda t, g: rms_norm(heads(t, NA_HEADS)) * g
    na_lat, na_ctx = neighbourhood_attention(
        qkn(lat[0], q_gain), qkn(lat[1], k_gain), heads(lat[2], NA_HEADS),
        qkn(ctx[0], q_gain), qkn(ctx[1], k_gain), heads(ctx[2], NA_HEADS), rpb)

    def ml_inputs(p):
        q = heads(p[3], ML_HEADS).astype(f32) * ML_QK_DIM ** -0.5
        k = heads(p[4], ML_HEADS).astype(f32)
        v = heads(p[5], ML_HEADS).astype(f32)
        g = (p[7] + gate_bias.reshape(-1)).astype(f32)
        bb, T, _ = g.shape
        g = g.reshape(bb, T, 4, ML_HEADS).transpose(2, 0, 3, 1)
        fwd = (q, k, v, g[0], jax.nn.log_sigmoid(g[1]))
        bwd = (q, k, v, g[2], jax.nn.log_sigmoid(g[3]))
        return fwd, bwd

    c_fwd, c_bwd = ml_inputs(ctx)
    l_fwd, l_bwd = ml_inputs(lat)
    b = h_lat.shape[0]
    state0 = (jnp.zeros((b, ML_HEADS, ML_V_DIM, ML_QK_DIM), f32),
              jnp.zeros((b, ML_HEADS, ML_QK_DIM), f32),
              jnp.zeros((b, ML_HEADS), f32))
    ml_ctx, ml_lat = bidirectional(mlstm_chunk, ML_CHUNK, state0, c_fwd, l_fwd, c_bwd, l_bwd)
    ml_out = lambda hs, p: merge_heads(rms_norm(hs)).astype(dtype) * ml_gain * jax.nn.sigmoid(p[6])
    y_lat = jnp.concatenate([merge_heads(na_lat), ml_out(ml_lat, lat)], axis=-1)
    y_ctx = jnp.concatenate([merge_heads(na_ctx), ml_out(ml_ctx, ctx)], axis=-1)
    return y_lat, y_ctx


def mixer_hgrn_ssd(h_lat, h_ctx, lower_bound, w_in, hg_gain, conv_w, conv_b, dt_bias, a_log, d_skip, ssd_gain):
    dtype = h_lat.dtype
    f32 = jnp.float32
    lat = split_cols(h_lat @ w_in, ODD_SPLIT)
    ctx = split_cols(h_ctx @ w_in, ODD_SPLIT)
    b = h_lat.shape[0]
    lbound = lower_bound.reshape(HG_HEADS, 1, HG_K_DIM).astype(f32)

    def hg_inputs(p):
        q = jax.nn.silu(heads(p[0], HG_HEADS).astype(f32))
        v = jax.nn.silu(heads(p[3], HG_HEADS).astype(f32))

        def one_dir(fp):
            f = lbound + (1 - lbound) * jax.nn.sigmoid(heads(fp, HG_HEADS).astype(f32))
            return (q, 1 - f, jnp.log(f), v)

        return one_dir(p[1]), one_dir(p[2])

    c_fwd, c_bwd = hg_inputs(ctx)
    l_fwd, l_bwd = hg_inputs(lat)
    hg0 = jnp.zeros((b, HG_HEADS, HG_K_DIM, HG_V_DIM), f32)
    hg_ctx, hg_lat = bidirectional(hgrn_chunk, HG_CHUNK, hg0, c_fwd, l_fwd, c_bwd, l_bwd)
    hg_out = lambda o, p: merge_heads(rms_norm(o)).astype(dtype) * hg_gain * jax.nn.silu(p[4])
    A = -jnp.exp(a_log.astype(f32))

    def ssd_inputs(p):
        xbc = jax.nn.silu(centred_conv(p[6], conv_w, conv_b))
        xs, bm, cm = split_cols(xbc, (SSD_W, SSD_BC_W, SSD_BC_W))
        xh = heads(xs, SSD_HEADS).astype(f32)
        bm = heads(bm, SSD_GROUPS).astype(f32)
        cm = heads(cm, SSD_GROUPS).astype(f32)
        bb, T, _ = p[7].shape
        dts = jax.nn.softplus(p[7].astype(f32).reshape(bb, T, 2, SSD_HEADS) + dt_bias.astype(f32))
        dts = dts.transpose(2, 0, 3, 1)
        fwd = (xh, dts[0], dts[0] * A[0][:, None], bm, cm)
        bwd = (xh, dts[1], dts[1] * A[1][:, None], bm, cm)
        return fwd, bwd, xh

    sc_fwd, sc_bwd, xh_ctx = ssd_inputs(ctx)
    sl_fwd, sl_bwd, xh_lat = ssd_inputs(lat)
    ssd0 = jnp.zeros((b, SSD_HEADS, SSD_HEAD_DIM, SSD_STATE), f32)
    ys_ctx, ys_lat = bidirectional(ssd_chunk, SSD_CHUNK, ssd0, sc_fwd, sl_fwd, sc_bwd, sl_bwd)

    def ssd_out(ysum, xh, z):
        y = merge_heads(ysum + d_skip.astype(f32)[:, None, None] * xh) * jax.nn.silu(z.astype(f32))
        bb, T, _ = y.shape
        y = rms_norm(y.reshape(bb, T, SSD_GROUPS, -1)).reshape(bb, T, SSD_W)
        return y.astype(dtype) * ssd_gain

    y_lat = jnp.concatenate([hg_out(hg_lat, lat), ssd_out(ys_lat, xh_lat, lat[5])], axis=-1)
    y_ctx = jnp.concatenate([hg_out(hg_ctx, ctx), ssd_out(ys_ctx, xh_ctx, ctx[5])], axis=-1)
    return y_lat, y_ctx


def setup_inputs(seed: int = 0) -> dict:
    key = jax.random.key(seed)
    ks = iter(jax.random.split(key, 48))
    f32 = jnp.float32
    nrm = lambda shape, scale: jax.random.normal(next(ks), shape, f32) * scale
    gain = lambda n: 1.0 + 0.02 * jax.random.normal(next(ks), (n,), f32)
    d = D_MODEL
    inp = {}
    inp['x'] = nrm((BATCH, SEQ, d), 1.0)
    inp['c'] = nrm((BATCH, d), 1.0)
    inp['ctx'] = nrm((BATCH, CTX_LEN, d), 1.0)
    inp['c_ctx'] = nrm((d,), 1.0)
    inp['hgrn_lb_logits'] = nrm((DEPTH, HG_K_W), 0.1)
    inp['l0_mod_w'] = nrm((d, N_MOD * d), d ** -0.5)
    inp['l0_mod_b'] = nrm((N_MOD * d,), 0.02)
    inp['l0_w_in'] = nrm((d, EVEN_IN), d ** -0.5)
    inp['l0_q_gain'] = gain(NA_HEAD_DIM)
    inp['l0_k_gain'] = gain(NA_HEAD_DIM)
    inp['l0_rpb'] = nrm((NA_HEADS, 2 * NA_WIN_H - 1, 2 * NA_WIN_W - 1), 0.1)
    inp['l0_gate_bias'] = jnp.array([[0.0], [3.0], [0.0], [3.0]], f32) + nrm((4, ML_HEADS), 0.1)
    inp['l0_ml_gain'] = gain(ML_W)
    inp['l0_w_out'] = nrm((EVEN_MIX, d), EVEN_MIX ** -0.5)
    inp['l0_ffn_w1'] = nrm((d, FFN_HIDDEN), d ** -0.5)
    inp['l0_ffn_w3'] = nrm((d, FFN_HIDDEN), d ** -0.5)
    inp['l0_ffn_w2'] = nrm((FFN_HIDDEN, d), FFN_HIDDEN ** -0.5)
    inp['l1_mod_w'] = nrm((d, N_MOD * d), d ** -0.5)
    inp['l1_mod_b'] = nrm((N_MOD * d,), 0.02)
    inp['l1_w_in'] = nrm((d, ODD_IN), d ** -0.5)
    inp['l1_hg_gain'] = gain(HG_W)
    inp['l1_conv_w'] = nrm((SSD_CONV, SSD_XBC), SSD_CONV ** -0.5)
    inp['l1_conv_b'] = nrm((SSD_XBC,), 0.02)
    u = jax.random.uniform(next(ks), (2, SSD_HEADS), f32)
    dt0 = jnp.exp(u * (math.log(0.1) - math.log(1e-3)) + math.log(1e-3))
    inp['l1_dt_bias'] = dt0 + jnp.log(-jnp.expm1(-dt0))
    inp['l1_a_log'] = jnp.log(jax.random.uniform(next(ks), (2, SSD_HEADS), f32, minval=1.0, maxval=16.0))
    inp['l1_d_skip'] = 1.0 + nrm((SSD_HEADS,), 0.1)
    inp['l1_ssd_gain'] = gain(SSD_W)
    inp['l1_w_out'] = nrm((ODD_MIX, d), ODD_MIX ** -0.5)
    inp['l1_ffn_w1'] = nrm((d, FFN_HIDDEN), d ** -0.5)
    inp['l1_ffn_w3'] = nrm((d, FFN_HIDDEN), d ** -0.5)
    inp['l1_ffn_w2'] = nrm((FFN_HIDDEN, d), FFN_HIDDEN ** -0.5)
    return inp


def reference(x, c, ctx, c_ctx, hgrn_lb_logits,
              l0_mod_w, l0_mod_b, l0_w_in, l0_q_gain, l0_k_gain, l0_rpb, l0_gate_bias, l0_ml_gain,
              l0_w_out, l0_ffn_w1, l0_ffn_w3, l0_ffn_w2,
              l1_mod_w, l1_mod_b, l1_w_in, l1_hg_gain, l1_conv_w, l1_conv_b, l1_dt_bias, l1_a_log,
              l1_d_skip, l1_ssd_gain, l1_w_out, l1_ffn_w1, l1_ffn_w3, l1_ffn_w2):
    p = jax.nn.softmax(hgrn_lb_logits.astype(jnp.float32), axis=0)
    lower_bounds = jnp.cumsum(p, axis=0) - p[0]
    layers = [
        ((l0_mod_w, l0_mod_b, l0_w_out, l0_ffn_w1, l0_ffn_w3, l0_ffn_w2),
         (l0_w_in, l0_q_gain, l0_k_gain, l0_rpb, l0_gate_bias, l0_ml_gain)),
        ((l1_mod_w, l1_mod_b, l1_w_out, l1_ffn_w1, l1_ffn_w3, l1_ffn_w2),
         (l1_w_in, l1_hg_gain, l1_conv_w, l1_conv_b, l1_dt_bias, l1_a_log, l1_d_skip, l1_ssd_gain)),
    ]
    x_lat, x_ctx = x, ctx
    for layer in range(DEPTH):
        (mod_w, mod_b, w_out, w1, w3, w2), mix_p = layers[layer]
        sh1, sc1, g1, sh2, sc2, g2 = [m[:, None, :] for m in modulation(c, mod_w, mod_b)]
        csh1, csc1, cg1, csh2, csc2, cg2 = modulation(c_ctx, mod_w, mod_b)
        a_lat = modulate(x_lat, sh1, sc1)
        a_ctx = modulate(x_ctx, csh1, csc1)
        if layer % 2 == 0:
            y_lat, y_ctx = mixer_na_mlstm(a_lat, a_ctx, *mix_p)
        else:
            y_lat, y_ctx = mixer_hgrn_ssd(a_lat, a_ctx, lower_bounds[layer], *mix_p)
        x_lat = x_lat + g1 * (y_lat @ w_out)
        x_lat = x_lat + g2 * swiglu(modulate(x_lat, sh2, sc2), w1, w3, w2)
        if layer < DEPTH - 1:
            x_ctx = x_ctx + cg1 * (y_ctx @ w_out)
            x_ctx = x_ctx + cg2 * swiglu(modulate(x_ctx, csh2, csc2), w1, w3, w2)
    return x_lat
```

```cpp
#include <hip/hip_runtime.h>
#include <hip/hip_cooperative_groups.h>
#include <cstdio>
#include <cstdint>
namespace cg = cooperative_groups;
namespace pg8 {
#define PG8_LAS __attribute__((address_space(3)))
typedef unsigned short bf16_t;
typedef short bf16x8 __attribute__((ext_vector_type(8)));
typedef float f32x4 __attribute__((ext_vector_type(4)));
typedef unsigned u32x4 __attribute__((ext_vector_type(4)));
constexpr int BM = 256, BK = 64, HALF = 128, HTB = HALF * BK * 2  , STAGE_BYTES = 8 * HTB, NXCD = 8, WGM = 8;

__host__ __device__ __forceinline__ int lds_byte(int r, int c) { const int st = (r >> 4) * 2 + (c >> 5), rr = r & 15, cc = c & 31, ob = rr * 64 + cc * 2; return st * 1024 + (ob ^ (((ob >> 9) & 1) << 5)); }
__host__ __device__ __forceinline__ void stage_rc(int b, int& R, int& C) { const int st = b / 1024, sb = b % 1024, swz = sb ^ (((sb >> 9) & 1) << 5); R = (st >> 1) * 16 + swz / 64; C = (st & 1) * 32 + (swz % 64) / 2; }
__host__ __device__ __forceinline__ int perm32(int rho) { const int n = rho >> 4, i = rho & 15; return 8 * (i >> 2) + 4 * n + (i & 3); }

struct Unit { int pm, pn, ks; };
struct Gemm { const bf16_t* A; const bf16_t* Bt; int M, N, K; int ld = 0; };

struct StaticOrder {
    int nM, nN, nwg, G, c;
    __host__ __device__ void init(int M, int N, int G_, int c_) { nM = M / BM; nN = N / BM; nwg = nM * nN; G = G_; c = c_; }
    __host__ __device__ bool next(int i, Unit& u) const {
        const long L = (long)i * G + c; if (L >= nwg) return false;
        int wgid = (int)L; { const int q = nwg / NXCD, r = nwg % NXCD, xcd = wgid % NXCD, off = wgid / NXCD; wgid = (xcd < r ? xcd * (q + 1) : r * (q + 1) + (xcd - r) * q) + off; }
        const int nig = WGM * nN, gid = wgid / nig, fm = gid * WGM, gsz = (nM - fm) < WGM ? (nM - fm) : WGM;
        u.pm = fm + ((wgid % nig) % gsz); u.pn = (wgid % nig) / gsz; u.ks = 0; return true;
    }
    __device__ __forceinline__ void a_ready(const Unit&) const {}
    __device__ __forceinline__ void done(const Unit&) const {}
};
__device__ __forceinline__ unsigned cvt_pk_bf16(float lo, float hi) { unsigned r; asm volatile("v_cvt_pk_bf16_f32 %0, %1, %2" : "=v"(r) : "v"(lo), "v"(hi)); return r; }
template <class Epi, class Sched, bool ALIGN_EPI = false, bool SP2 = false>
__device__ __forceinline__ void gemm_phase(PG8_LAS unsigned char* lds, const Gemm g, const Sched& S, const Epi& E) {
    const int tid = threadIdx.x, wid = __builtin_amdgcn_readfirstlane(tid >> 6), lane = tid & 63, wr = wid >> 2, wc = wid & 3, fr = lane & 15, fq = lane >> 4;
    const int K = g.K, nt = K / BK, LD = g.ld ? g.ld : g.K;
    unsigned voffA[2], voffB[2];
#pragma unroll
    for (int i = 0; i < 2; ++i) { int R, C; stage_rc(tid * 16 + i * 8192, R, C); const int Rb = Epi::PERM ? ((R & ~31) + perm32(R & 31)) : R;
        voffA[i] = (unsigned)(R * LD + C) * 2u; voffB[i] = (unsigned)(Rb * LD + C) * 2u; }
    const size_t kstep = (size_t)(BK * 2);
    const size_t hstep = (size_t)HALF * LD * 2;
    const size_t tstep = 2 * hstep;
    const unsigned ldsw = (unsigned)wid * 1024u;
    const int aoff = lds_byte(wr * 64 + fr, fq * 8), boff = lds_byte(wc * 32 + fr, fq * 8);
#define PG8_SA(b, h) (((b) * 2 + (h)) * HTB)
#define PG8_SB(b, h) ((4 + (b) * 2 + (h)) * HTB)
#define PG8_STAGE(bufoff, gbase, voff) do { _Pragma("unroll") for (int _i = 0; _i < 2; ++_i) \
        __builtin_amdgcn_global_load_lds((const unsigned*)((const char*)(gbase) + (voff)[_i]), (PG8_LAS unsigned*)(lds + (bufoff) + ldsw + _i * 8192), 16, 0, 0); } while (0)
#define PG8_LDA(dst, b, h) do { _Pragma("unroll") for (int m = 0; m < 4; ++m) _Pragma("unroll") for (int k = 0; k < 2; ++k) dst[m][k] = *(const PG8_LAS bf16x8*)(lds + PG8_SA(b, h) + aoff + m * 2048 + k * 1024); } while (0)
#define PG8_LDB(dst, b, h) do { _Pragma("unroll") for (int n = 0; n < 2; ++n) _Pragma("unroll") for (int k = 0; k < 2; ++k) dst[n][k] = *(const PG8_LAS bf16x8*)(lds + PG8_SB(b, h) + boff + n * 2048 + k * 1024); } while (0)
#define PG8_MMA(ai, bj, At, Bt) do { __builtin_amdgcn_s_setprio(1); _Pragma("unroll") for (int m = 0; m < 4; ++m) _Pragma("unroll") for (int n = 0; n < 2; ++n) _Pragma("unroll") for (int k = 0; k < 2; ++k) \
        acc[ai][bj][m][n] = __builtin_amdgcn_mfma_f32_16x16x32_bf16(Bt[n][k], At[m][k], acc[ai][bj][m][n], 0, 0, 0); __builtin_amdgcn_s_setprio(0); } while (0)
#define PG8_WAIT_V(n) asm volatile("s_waitcnt vmcnt(" #n ")" ::: "memory")
#define PG8_WAIT_L(n) asm volatile("s_waitcnt lgkmcnt(" #n ")" ::: "memory")
#define PG8_BAR __builtin_amdgcn_s_barrier()
#define PG8_SCHED __builtin_amdgcn_sched_barrier(0)
    Unit cur, nxt; int ui = 0;
    if (!S.next(0, cur)) return;
    f32x4 acc[2][2][4][2];
#pragma unroll
    for (int a = 0; a < 2; ++a)
#pragma unroll
        for (int b = 0; b < 2; ++b)
#pragma unroll
            for (int m = 0; m < 4; ++m)
#pragma unroll
                for (int n = 0; n < 2; ++n) acc[a][b][m][n] = (f32x4){0.f, 0.f, 0.f, 0.f};
    bf16x8 At[4][2], B0[2][2], B1[2][2];
    const char* cA = (const char*)g.A + (size_t)cur.pm * tstep + (size_t)cur.ks * K * 2; const char* cB = (const char*)g.Bt + (size_t)cur.pn * tstep + (size_t)cur.ks * K * 2;
    S.a_ready(cur);
    if constexpr (SP2) {
        PG8_STAGE(PG8_SB(0, 0), cB, voffB); PG8_STAGE(PG8_SB(0, 1), cB + hstep, voffB); PG8_STAGE(PG8_SA(0, 0), cA, voffA); PG8_STAGE(PG8_SA(0, 1), cA + hstep, voffA);
        if (wr == 1) PG8_BAR;
        PG8_WAIT_V(2); PG8_BAR;
        PG8_STAGE(PG8_SB(1, 0), cB + kstep, voffB); PG8_STAGE(PG8_SA(1, 0), cA + kstep, voffA); PG8_STAGE(PG8_SB(1, 1), cB + hstep + kstep, voffB);
        PG8_WAIT_V(6); PG8_BAR;
    } else {
        PG8_STAGE(PG8_SB(0, 0), cB, voffB); PG8_STAGE(PG8_SA(0, 0), cA, voffA); PG8_STAGE(PG8_SB(0, 1), cB + hstep, voffB); PG8_STAGE(PG8_SA(0, 1), cA + hstep, voffA);
        if (wr == 1) PG8_BAR;
        PG8_WAIT_V(4); PG8_BAR;
        PG8_STAGE(PG8_SB(1, 0), cB + kstep, voffB); PG8_STAGE(PG8_SA(1, 0), cA + kstep, voffA); PG8_STAGE(PG8_SB(1, 1), cB + hstep + kstep, voffB);
        PG8_WAIT_V(6); PG8_BAR;
    }
    for (;;) {
        const bool has_next = S.next(ui + 1, nxt);
        const char* nA = has_next ? (const char*)g.A + (size_t)nxt.pm * tstep + (size_t)nxt.ks * K * 2 : cA; const char* nB = has_next ? (const char*)g.Bt + (size_t)nxt.pn * tstep + (size_t)nxt.ks * K * 2 : cB;
        for (int t = 0; t < nt; t += 2) {
            const bool last = (t == nt - 2);
            const char* a1 = cA + (size_t)(t + 1) * kstep;
            const char* a2 = last ? nA : cA + (size_t)(t + 2) * kstep; const char* b2 = last ? nB : cB + (size_t)(t + 2) * kstep;
            const char* a3 = a2 + kstep; const char* b3 = b2 + kstep;
            if (last && has_next) S.a_ready(nxt);
            if constexpr (SP2) {
            PG8_LDB(B0, 0, 0); PG8_LDB(B1, 0, 1); PG8_SCHED; PG8_LDA(At, 0, 0); PG8_STAGE(PG8_SA(1, 1), a1 + hstep, voffA);
            PG8_WAIT_V(8); PG8_WAIT_L(0); PG8_BAR; PG8_MMA(0, 0, At, B0); PG8_MMA(0, 1, At, B1); PG8_BAR; PG8_SCHED;
            PG8_LDA(At, 0, 1); PG8_STAGE(PG8_SB(0, 0), b2, voffB); PG8_STAGE(PG8_SB(0, 1), b2 + hstep, voffB); PG8_STAGE(PG8_SA(0, 0), a2, voffA);
            PG8_WAIT_V(8); PG8_WAIT_L(0); PG8_BAR; PG8_MMA(1, 0, At, B0); PG8_MMA(1, 1, At, B1); PG8_BAR; PG8_SCHED;
            PG8_LDB(B0, 1, 0); PG8_LDB(B1, 1, 1); PG8_SCHED; PG8_LDA(At, 1, 0); PG8_STAGE(PG8_SA(0, 1), a2 + hstep, voffA);
            PG8_WAIT_V(8); PG8_WAIT_L(0); PG8_BAR; PG8_MMA(0, 0, At, B0); PG8_MMA(0, 1, At, B1); PG8_BAR; PG8_SCHED;
            PG8_LDA(At, 1, 1); PG8_STAGE(PG8_SB(1, 0), b3, voffB); PG8_STAGE(PG8_SB(1, 1), b3 + hstep, voffB); PG8_STAGE(PG8_SA(1, 0), a3, voffA);
            PG8_WAIT_V(8); PG8_WAIT_L(0); PG8_BAR; PG8_MMA(1, 0, At, B0); PG8_MMA(1, 1, At, B1); PG8_BAR; PG8_SCHED;
            } else {
            PG8_LDB(B0, 0, 0); PG8_SCHED; PG8_LDA(At, 0, 0); PG8_STAGE(PG8_SA(1, 1), a1 + hstep, voffA);
            PG8_WAIT_L(8); PG8_BAR; PG8_WAIT_L(0); PG8_MMA(0, 0, At, B0); PG8_BAR; PG8_SCHED;
            PG8_LDB(B1, 0, 1); PG8_STAGE(PG8_SB(0, 0), b2, voffB);
            PG8_BAR; PG8_WAIT_L(0); PG8_MMA(0, 1, At, B1); PG8_BAR;
            PG8_LDA(At, 0, 1); PG8_STAGE(PG8_SA(0, 0), a2, voffA);
            PG8_BAR; PG8_WAIT_L(0); PG8_MMA(1, 0, At, B0); PG8_BAR; PG8_SCHED;
            PG8_STAGE(PG8_SB(0, 1), b2 + hstep, voffB);
            PG8_WAIT_V(6); PG8_BAR; PG8_MMA(1, 1, At, B1); PG8_BAR;
            PG8_LDB(B0, 1, 0); PG8_SCHED; PG8_LDA(At, 1, 0); PG8_STAGE(PG8_SA(0, 1), a2 + hstep, voffA);
            PG8_WAIT_L(8); PG8_BAR; PG8_WAIT_L(0); PG8_MMA(0, 0, At, B0); PG8_BAR; PG8_SCHED;
            PG8_LDB(B1, 1, 1); PG8_STAGE(PG8_SB(1, 0), b3, voffB);
            PG8_BAR; PG8_WAIT_L(0); PG8_MMA(0, 1, At, B1); PG8_BAR;
            PG8_LDA(At, 1, 1); PG8_STAGE(PG8_SA(1, 0), a3, voffA);
            PG8_BAR; PG8_WAIT_L(0); PG8_MMA(1, 0, At, B0); PG8_BAR; PG8_SCHED;
            PG8_STAGE(PG8_SB(1, 1), b3 + hstep, voffB);
            PG8_WAIT_V(6); PG8_BAR; PG8_MMA(1, 1, At, B1); PG8_BAR;
            }
        }
        if constexpr (ALIGN_EPI) { if (wr == 0) PG8_BAR; }
        if constexpr (!Epi::AFTER_DRAIN) { E(acc, cur, wr, wc, fr, fq); S.done(cur); }
        if (!has_next) break;
#pragma unroll
        for (int a = 0; a < 2; ++a)
#pragma unroll
            for (int b = 0; b < 2; ++b)
#pragma unroll
                for (int m = 0; m < 4; ++m)
#pragma unroll
                    for (int n = 0; n < 2; ++n) acc[a][b][m][n] = (f32x4){0.f, 0.f, 0.f, 0.f};
        cur = nxt; cA = nA; cB = nB; ++ui;
        if constexpr (ALIGN_EPI) { if (wr == 1) PG8_BAR; }
    }
    PG8_WAIT_V(0);
    if constexpr (!ALIGN_EPI) { if (wr == 0) PG8_BAR; }
    PG8_BAR;
    if constexpr (Epi::AFTER_DRAIN) { E.fused(acc, cur, wr, wc, fr, fq, lds, wid, lane); S.done(cur); }
#undef PG8_SA
#undef PG8_SB
#undef PG8_STAGE
#undef PG8_LDA
#undef PG8_LDB
#undef PG8_MMA
#undef PG8_WAIT_V
#undef PG8_WAIT_L
#undef PG8_BAR
#undef PG8_SCHED
}
}


#define LAS __attribute__((address_space(3)))
typedef unsigned short bf16;
typedef float f32x4 __attribute__((ext_vector_type(4)));
typedef float f32x2 __attribute__((ext_vector_type(2)));
typedef short bf16x8 __attribute__((ext_vector_type(8)));
typedef unsigned u32x4 __attribute__((ext_vector_type(4)));
typedef unsigned u32x2 __attribute__((ext_vector_type(2)));

constexpr int NWAVES = 8, NTHR = 512;
constexpr int DM = 2048, NB = 4, SEQ = 4096, CTXL = 256, FFH = 5632;
constexpr int MLAT = NB * SEQ, MCTX = NB * CTXL, MTOT = MLAT + MCTX;
constexpr int EVEN_IN = 6160, ODD_IN = 7712;
constexpr int LDP0 = 6144, LDP1 = 7680;
constexpr int NMODC = 6 * DM;
constexpr float EPS = 1e-6f;

constexpr size_t MiB = 1u << 20;
constexpr size_t WS_MOD = 0, WS_WIN = 1 * MiB, WS_WOUT = 32 * MiB, WS_W13 = 40 * MiB, WS_W2 = 84 * MiB, WS_A = 106 * MiB, WS_P = 174 * MiB,
                 WS_G = 429 * MiB, WS_Y = 432 * MiB, WS_VT = 500 * MiB, WS_DIRB = 551 * MiB, WS_XC = 619 * MiB, WS_PART = 627 * MiB, WS_XB = 659 * MiB, WS_END = 723 * MiB;
constexpr size_t WS_BAR = 768 * 1024, BAR_BYTES = 16384;
constexpr size_t DIRSZ = (size_t)MTOT * 1024;
constexpr int LDS_BYTES = 163840;

typedef __bf16 bf16x2_t __attribute__((ext_vector_type(2)));
__device__ __forceinline__ unsigned pk2(float lo, float hi) { const f32x2 v = {lo, hi}; const bf16x2_t b = __builtin_convertvector(v, bf16x2_t); return __builtin_bit_cast(unsigned, b); }
__device__ __forceinline__ unsigned f2bf(float f) { return pk2(f, f) & 0xffffu; }
__device__ __forceinline__ float bflo(unsigned u) { return __builtin_bit_cast(float, u << 16); }
__device__ __forceinline__ float bfhi(unsigned u) { return __builtin_bit_cast(float, u & 0xffff0000u); }
__device__ __forceinline__ float fexp(float x) { return __expf(x); }
__device__ __forceinline__ float sigmoidf_(float x) { return __builtin_amdgcn_rcpf(1.f + __expf(-x)); }
__device__ __forceinline__ float siluf_(float x) { return x * __builtin_amdgcn_rcpf(1.f + __expf(-x)); }
__device__ __forceinline__ float softplusf_(float x) { return fmaxf(x, 0.f) + __logf(1.f + __expf(-fabsf(x))); }
__device__ __forceinline__ float logsigmoidf_(float x) { return fminf(x, 0.f) - __logf(1.f + __expf(-fabsf(x))); }
__device__ __forceinline__ float wave_sum(float v) {
#pragma unroll
    for (int o = 1; o < 64; o <<= 1) v += __shfl_xor(v, o);
    return v;
}
__device__ __forceinline__ float sum8(float v) {
    v += __builtin_bit_cast(float, __builtin_amdgcn_update_dpp(0, __builtin_bit_cast(int, v), 0xB1, 0xF, 0xF, true));
    v += __builtin_bit_cast(float, __builtin_amdgcn_update_dpp(0, __builtin_bit_cast(int, v), 0x4E, 0xF, 0xF, true));
    v += __builtin_bit_cast(float, __builtin_amdgcn_update_dpp(0, __builtin_bit_cast(int, v), 0x141, 0xF, 0xF, true));
    return v;
}
template <int CTRL, int RM> __device__ __forceinline__ float dppmov(float oldv, float v) {
    return __builtin_bit_cast(float, __builtin_amdgcn_update_dpp(__builtin_bit_cast(int, oldv), __builtin_bit_cast(int, v), CTRL, RM, 0xF, false)); }
__device__ __forceinline__ float wave_scan_add(float x) {
    x += dppmov<0x111, 0xF>(0.f, x); x += dppmov<0x112, 0xF>(0.f, x); x += dppmov<0x114, 0xF>(0.f, x); x += dppmov<0x118, 0xF>(0.f, x);
    x += dppmov<0x142, 0xA>(0.f, x); x += dppmov<0x143, 0xC>(0.f, x); return x; }
__device__ __forceinline__ float wave_scan_max(float x) {
    const float NEG = -3.0e38f;
    x = fmaxf(x, dppmov<0x111, 0xF>(NEG, x)); x = fmaxf(x, dppmov<0x112, 0xF>(NEG, x)); x = fmaxf(x, dppmov<0x114, 0xF>(NEG, x)); x = fmaxf(x, dppmov<0x118, 0xF>(NEG, x));
    x = fmaxf(x, dppmov<0x142, 0xA>(NEG, x)); x = fmaxf(x, dppmov<0x143, 0xC>(NEG, x)); return x; }
__device__ __forceinline__ float lane63(float x) { return __builtin_bit_cast(float, __builtin_amdgcn_readlane(__builtin_bit_cast(int, x), 63)); }
#define LDS_WAIT() asm volatile("s_waitcnt lgkmcnt(0)" ::: "memory")

struct EpiProj {
    static constexpr bool PERM = true, AFTER_DRAIN = false;
    bf16* O; int ldc; int ntile_main; float* G; int ng;
    __device__ __forceinline__ void operator()(const f32x4 (&acc)[2][2][4][2], const pg8::Unit& u, int wr, int wc, int fr, int fq) const {
        const int row0 = u.pm * 256 + wr * 64 + fr;
        if (u.pn < ntile_main) {
            const int col0 = u.pn * 256 + wc * 32 + 8 * fq;
#pragma unroll
            for (int ai = 0; ai < 2; ++ai)
#pragma unroll
                for (int m = 0; m < 4; ++m) { bf16* rowp = O + (size_t)(row0 + ai * 128 + m * 16) * ldc + col0;
#pragma unroll
                    for (int bj = 0; bj < 2; ++bj) { const f32x4 v0 = acc[ai][bj][m][0], v1 = acc[ai][bj][m][1];
                        u32x4 w; w.x = pg8::cvt_pk_bf16(v0[0], v0[1]); w.y = pg8::cvt_pk_bf16(v0[2], v0[3]); w.z = pg8::cvt_pk_bf16(v1[0], v1[1]); w.w = pg8::cvt_pk_bf16(v1[2], v1[3]);
                        *(u32x4*)(rowp + bj * 128) = w; } }
        } else if (wc == 0) {
#pragma unroll
            for (int ai = 0; ai < 2; ++ai)
#pragma unroll
                for (int m = 0; m < 4; ++m) { float* rowp = G + (size_t)(row0 + ai * 128 + m * 16) * 32;
#pragma unroll
                    for (int n = 0; n < 2; ++n) { const int c = 8 * fq + 4 * n; if (c < ng) *(f32x4*)(rowp + c) = acc[ai][0][m][n]; } }
        }
    }
};
constexpr int NTG = MTOT / 4;
struct EpiBf {
    static constexpr bool PERM = true, AFTER_DRAIN = false;
    bf16* O; int ldc;
    __device__ __forceinline__ void operator()(const f32x4 (&acc)[2][2][4][2], const pg8::Unit& u, int wr, int wc, int fr, int fq) const {
        const int row0 = u.pm * 256 + wr * 64 + fr, col0 = u.pn * 256 + wc * 32 + 8 * fq;
#pragma unroll
        for (int ai = 0; ai < 2; ++ai)
#pragma unroll
            for (int m = 0; m < 4; ++m) { const int row = row0 + ai * 128 + m * 16, hh = row >> 7, d = row & 127;
#pragma unroll
                for (int bj = 0; bj < 2; ++bj) { const f32x4 v0 = acc[ai][bj][m][0], v1 = acc[ai][bj][m][1];
                    const int tg = (col0 + bj * 128) >> 2;
                    u32x2 w0, w1; w0.x = pg8::cvt_pk_bf16(v0[0], v0[1]); w0.y = pg8::cvt_pk_bf16(v0[2], v0[3]); w1.x = pg8::cvt_pk_bf16(v1[0], v1[1]); w1.y = pg8::cvt_pk_bf16(v1[2], v1[3]);
                    *(u32x2*)(O + (((size_t)hh * NTG + tg) * 128 + d) * 4) = w0; *(u32x2*)(O + (((size_t)hh * NTG + tg + 1) * 128 + d) * 4) = w1; } }
    }
};
struct EpiSwiglu {
    static constexpr bool PERM = true, AFTER_DRAIN = false;
    bf16* H; int ldc;
    __device__ __forceinline__ void operator()(const f32x4 (&acc)[2][2][4][2], const pg8::Unit& u, int wr, int wc, int fr, int fq) const {
        const int row0 = u.pm * 256 + wr * 64 + fr, col0 = u.pn * 128 + wc * 32 + 8 * fq;
#pragma unroll
        for (int ai = 0; ai < 2; ++ai)
#pragma unroll
            for (int m = 0; m < 4; ++m) {
                float h[8];
#pragma unroll
                for (int n = 0; n < 2; ++n)
#pragma unroll
                    for (int j = 0; j < 4; ++j) { const float a = acc[ai][0][m][n][j], b = acc[ai][1][m][n][j]; h[n * 4 + j] = a * __builtin_amdgcn_rcpf(1.f + __expf(-a)) * b; }
                u32x4 w; w.x = pg8::cvt_pk_bf16(h[0], h[1]); w.y = pg8::cvt_pk_bf16(h[2], h[3]); w.z = pg8::cvt_pk_bf16(h[4], h[5]); w.w = pg8::cvt_pk_bf16(h[6], h[7]);
                *(u32x4*)(H + (size_t)(row0 + ai * 128 + m * 16) * ldc + col0) = w; }
    }
};
template <bool SBF, bool DBF> struct EpiRes {
    static constexpr bool PERM = true, AFTER_DRAIN = false;
    const void* src; void* dst; const float* gate;
    __device__ __forceinline__ void operator()(const f32x4 (&acc)[2][2][4][2], const pg8::Unit& u, int wr, int wc, int fr, int fq) const {
        const int row0 = u.pm * 256 + wr * 64 + fr, col0 = u.pn * 256 + wc * 32 + 8 * fq;
        const float* g = gate + (size_t)(u.pm >> 4) * NMODC + col0;
        f32x4 gv[2][2];
#pragma unroll
        for (int bj = 0; bj < 2; ++bj)
#pragma unroll
            for (int n = 0; n < 2; ++n) gv[bj][n] = *(const f32x4*)(g + bj * 128 + n * 4);
        if (SBF) {
#pragma unroll
            for (int ai = 0; ai < 2; ++ai) {
                u32x4 sv[4][2];
#pragma unroll
                for (int m = 0; m < 4; ++m)
#pragma unroll
                    for (int bj = 0; bj < 2; ++bj) sv[m][bj] = *(const u32x4*)((const bf16*)src + (size_t)(row0 + ai * 128 + m * 16) * DM + col0 + bj * 128);
#pragma unroll
                for (int m = 0; m < 4; ++m) { const size_t off = (size_t)(row0 + ai * 128 + m * 16) * DM + col0;
#pragma unroll
                    for (int bj = 0; bj < 2; ++bj) { const u32x4 uu = sv[m][bj];
                        const f32x4 s0 = (f32x4){bflo(uu.x), bfhi(uu.x), bflo(uu.y), bfhi(uu.y)}, s1 = (f32x4){bflo(uu.z), bfhi(uu.z), bflo(uu.w), bfhi(uu.w)};
                        const f32x4 r0 = s0 + gv[bj][0] * acc[ai][bj][m][0], r1 = s1 + gv[bj][1] * acc[ai][bj][m][1];
                        if (DBF) { u32x4 w; w.x = pk2(r0[0], r0[1]); w.y = pk2(r0[2], r0[3]); w.z = pk2(r1[0], r1[1]); w.w = pk2(r1[2], r1[3]); *(u32x4*)((bf16*)dst + off + bj * 128) = w; }
                        else { *(f32x4*)((float*)dst + off + bj * 128) = r0; *(f32x4*)((float*)dst + off + bj * 128 + 4) = r1; } } }
            }
        } else {
#pragma unroll
            for (int ai = 0; ai < 2; ++ai)
#pragma unroll
                for (int mh = 0; mh < 2; ++mh) {
                    f32x4 sf[2][2][2];
#pragma unroll
                    for (int mm = 0; mm < 2; ++mm)
#pragma unroll
                        for (int bj = 0; bj < 2; ++bj) { const float* sp = (const float*)src + (size_t)(row0 + ai * 128 + (mh * 2 + mm) * 16) * DM + col0 + bj * 128; sf[mm][bj][0] = *(const f32x4*)sp; sf[mm][bj][1] = *(const f32x4*)(sp + 4); }
#pragma unroll
                    for (int mm = 0; mm < 2; ++mm) { const int m = mh * 2 + mm; const size_t off = (size_t)(row0 + ai * 128 + m * 16) * DM + col0;
#pragma unroll
                        for (int bj = 0; bj < 2; ++bj) { const f32x4 r0 = sf[mm][bj][0] + gv[bj][0] * acc[ai][bj][m][0], r1 = sf[mm][bj][1] + gv[bj][1] * acc[ai][bj][m][1];
                            if (DBF) { u32x4 w; w.x = pk2(r0[0], r0[1]); w.y = pk2(r0[2], r0[3]); w.z = pk2(r1[0], r1[1]); w.w = pk2(r1[2], r1[3]); *(u32x4*)((bf16*)dst + off + bj * 128) = w; }
                            else { *(f32x4*)((float*)dst + off + bj * 128) = r0; *(f32x4*)((float*)dst + off + bj * 128 + 4) = r1; } } }
                }
        }
    }
};

template <int MODE>
__device__ __forceinline__ void transpose_item(const float* W, int K, int N, bf16* WT, LAS float* scr, int item, int lane) {
    const int nblk = (N + 31) / 32, kb = item / nblk, nb = item % nblk, k0 = 64 * kb, n0 = 32 * nb;
    const int n4 = (lane & 7) * 4; const bool okc = (n0 + n4) < N;
    f32x4 vld[8];
#pragma unroll
    for (int i = 0; i < 8; ++i) { const int kk = (lane >> 3) + 8 * i; vld[i] = okc ? *(const f32x4*)(W + (size_t)(k0 + kk) * N + n0 + n4) : (f32x4){0.f, 0.f, 0.f, 0.f}; }
#pragma unroll
    for (int i = 0; i < 8; ++i) { const int kk = (lane >> 3) + 8 * i;
#pragma unroll
        for (int e = 0; e < 4; ++e) scr[kk * 33 + n4 + e] = vld[i][e]; }
    LDS_WAIT(); asm volatile("" ::: "memory");
    const int c = lane & 7;
#pragma unroll
    for (int j = 0; j < 4; ++j) { const int n = (lane >> 3) + 8 * j; const LAS float* s = scr + (8 * c) * 33 + n;
        u32x4 o; o.x = pk2(s[0 * 33], s[1 * 33]); o.y = pk2(s[2 * 33], s[3 * 33]); o.z = pk2(s[4 * 33], s[5 * 33]); o.w = pk2(s[6 * 33], s[7 * 33]);
        const int nn = n0 + n; const int row = MODE == 0 ? nn : ((nn >> 7) * 256 + (nn & 127) + (MODE == 2 ? 128 : 0));
        *(u32x4*)(WT + (size_t)row * K + k0 + 8 * c) = o; }
    LDS_WAIT(); asm volatile("" ::: "memory");
}
__device__ __forceinline__ void convert_weights(LAS unsigned char* lds, unsigned char* ws, const float* w_in, int n_in, const float* w_out, const float* w1, const float* w3, const float* w2, int which, int wg, int nwg) {
    const int lane = threadIdx.x & 63, wave = threadIdx.x >> 6;
    LAS float* scr = (LAS float*)(lds + wave * 16384);
    const int gw = wg * NWAVES + wave, NGW = nwg * NWAVES;
    const int I_IN = (DM / 64) * ((n_in + 31) / 32), I_O = (DM / 64) * (DM / 32), I_1 = (DM / 64) * (FFH / 32), I_2 = (FFH / 64) * (DM / 32);
    const int n0 = (which & 1) ? I_IN : 0, n1 = (which & 2) ? I_O : 0, n2 = (which & 4) ? I_1 : 0, n3 = (which & 8) ? I_1 : 0, n4 = (which & 16) ? I_2 : 0;
    for (int it = gw; it < n0 + n1 + n2 + n3 + n4; it += NGW) {
        int r = it;
        if (r < n0) { transpose_item<0>(w_in, DM, n_in, (bf16*)(ws + WS_WIN), scr, r, lane); continue; } r -= n0;
        if (r < n1) { transpose_item<0>(w_out, DM, DM, (bf16*)(ws + WS_WOUT), scr, r, lane); continue; } r -= n1;
        if (r < n2) { transpose_item<1>(w1, DM, FFH, (bf16*)(ws + WS_W13), scr, r, lane); continue; } r -= n2;
        if (r < n3) { transpose_item<2>(w3, DM, FFH, (bf16*)(ws + WS_W13), scr, r, lane); continue; } r -= n3;
        transpose_item<0>(w2, FFH, DM, (bf16*)(ws + WS_W2), scr, r, lane);
    }
}
__device__ __forceinline__ void mod_gemv(LAS unsigned char* lds, const float* c, const float* c_ctx, const float* mw0, const float* mb0, const float* mw1, const float* mb1, float* MOD, int it_lo, int it_hi, int wg, int nwg) {
    LAS float* scv = (LAS float*)lds;
    LAS float* red = (LAS float*)(lds + 40960);
    const int tid = threadIdx.x;
    __syncthreads();
    for (int idx = tid; idx < 5 * DM; idx += NTHR) { const int i = idx >> 11, k = idx & 2047; const float cv = (i < 4) ? c[i * DM + k] : c_ctx[k]; scv[idx] = siluf_(cv); }
    __syncthreads();
    const int rg = tid >> 3, cl = tid & 7;
    for (int it = it_lo + wg; it < it_hi; it += nwg) {
        const int layer = it / 384, c0 = (it % 384) * 32;
        const float* W = layer ? mw1 : mw0; const float* bias = layer ? mb1 : mb0;
        f32x4 acc[5];
#pragma unroll
        for (int i = 0; i < 5; ++i) acc[i] = (f32x4){0.f, 0.f, 0.f, 0.f};
#pragma unroll 8
        for (int s = 0; s < 32; ++s) { const int k = s * 64 + rg; const f32x4 w = *(const f32x4*)(W + (size_t)k * NMODC + c0 + cl * 4);
#pragma unroll
            for (int i = 0; i < 5; ++i) acc[i] += scv[i * DM + k] * w; }
#pragma unroll
        for (int i = 0; i < 5; ++i) *(LAS f32x4*)(red + (rg * 5 + i) * 32 + cl * 4) = acc[i];
        __syncthreads();
        if (tid < 160) { const int i = tid >> 5, col = tid & 31; float s = 0.f;
            for (int r = 0; r < 64; ++r) s += red[(r * 5 + i) * 32 + col];
            MOD[(size_t)(layer * 5 + i) * NMODC + c0 + col] = s + bias[c0 + col]; }
        __syncthreads();
    }
}

template <bool LATBF>
__device__ __forceinline__ void phase_modulate(const void* xl, const float* xc, const float* mod, int shc, int scc, bf16* A, int nrows,
                                               const float* part = nullptr, const float* csrc = nullptr, const float* cgate = nullptr, float* xc_out = nullptr) {
    const int lane = threadIdx.x & 63, wave = threadIdx.x >> 6;
    const int gw = blockIdx.x * NWAVES + wave, NGW = gridDim.x * NWAVES;
    constexpr int NR = LATBF ? 4 : 2;
    for (int row0 = gw; row0 < nrows; row0 += NR * NGW) {
        f32x4 v[NR][8];
#pragma unroll
        for (int k = 0; k < NR; ++k) { const int row = row0 + k * NGW;
            if (row < nrows) {
                if (row >= MLAT) {
                    const size_t ro = (size_t)(row - MLAT) * DM;
                    if (part != nullptr) {
#pragma unroll
                        for (int q = 0; q < 8; ++q) { const int c4 = 2 * lane + 128 * (q >> 1) + (q & 1);
                            const f32x4 p = (((const f32x4*)(part + ro))[c4] + ((const f32x4*)(part + (size_t)MCTX * DM + ro))[c4]) + (((const f32x4*)(part + (size_t)2 * MCTX * DM + ro))[c4] + ((const f32x4*)(part + (size_t)3 * MCTX * DM + ro))[c4]);
                            v[k][q] = ((const f32x4*)(csrc + ro))[c4] + ((const f32x4*)cgate)[c4] * p; ((f32x4*)(xc_out + ro))[c4] = v[k][q]; }
                    } else {
#pragma unroll
                        for (int q = 0; q < 8; ++q) v[k][q] = ((const f32x4*)(xc + ro))[2 * lane + 128 * (q >> 1) + (q & 1)];
                    }
                } else if (LATBF) {
#pragma unroll
                    for (int j = 0; j < 4; ++j) { const u32x4 uu = ((const u32x4*)((const bf16*)xl + (size_t)row * DM))[lane + 64 * j];
                        v[k][2 * j] = (f32x4){bflo(uu.x), bfhi(uu.x), bflo(uu.y), bfhi(uu.y)}; v[k][2 * j + 1] = (f32x4){bflo(uu.z), bfhi(uu.z), bflo(uu.w), bfhi(uu.w)}; }
                } else {
#pragma unroll
                    for (int q = 0; q < 8; ++q) v[k][q] = ((const f32x4*)((const float*)xl + (size_t)row * DM))[2 * lane + 128 * (q >> 1) + (q & 1)];
                }
            } }
#pragma unroll
        for (int k = 0; k < NR; ++k) { const int row = row0 + k * NGW;
            if (row < nrows) {
                const int bi = row < MLAT ? (row >> 12) : 4;
                const f32x4* sh = (const f32x4*)(mod + (size_t)bi * NMODC + shc * DM); const f32x4* sc = (const f32x4*)(mod + (size_t)bi * NMODC + scc * DM);
                float ss = 0.f;
#pragma unroll
                for (int q = 0; q < 8; ++q) ss += (v[k][q].x * v[k][q].x + v[k][q].y * v[k][q].y) + (v[k][q].z * v[k][q].z + v[k][q].w * v[k][q].w);
                const float r = __builtin_amdgcn_rsqf(wave_sum(ss) * (1.f / DM) + EPS);
                u32x4* o = (u32x4*)(A + (size_t)row * DM);
#pragma unroll
                for (int j = 0; j < 4; ++j) { const int c4 = 2 * lane + 128 * j;
                    const f32x4 y0 = v[k][2 * j] * r * (sc[c4] + 1.f) + sh[c4], y1 = v[k][2 * j + 1] * r * (sc[c4 + 1] + 1.f) + sh[c4 + 1];
                    u32x4 w; w.x = pk2(y0.x, y0.y); w.y = pk2(y0.z, y0.w); w.z = pk2(y1.x, y1.y); w.w = pk2(y1.z, y1.w); o[lane + 64 * j] = w; }
            } }
    }
}

__device__ __forceinline__ float qmax4(float v) { v = fmaxf(v, __shfl_xor(v, 16)); v = fmaxf(v, __shfl_xor(v, 32)); return v; }
__device__ __forceinline__ float qsum4(float v) { v += __shfl_xor(v, 16); v += __shfl_xor(v, 32); return v; }

__device__ __forceinline__ void na_tile(int wt, const bf16* P, const bf16* Vt, const float* qg, const float* kg, const float* rpb, bf16* Y, int lane) {
    const bool isctx = wt >= 8192;
    int b, h, r = 0, j = 0, qrow0;
    if (!isctx) { j = wt & 3; r = (wt >> 2) & 63; h = (wt >> 8) & 7; b = wt >> 11; qrow0 = b * SEQ + r * 64 + j * 16; }
    else { const int x = wt - 8192; h = (x >> 4) & 7; b = x >> 7; qrow0 = MLAT + b * CTXL + (x & 15) * 16; }
    const int li = lane & 15, quad = lane >> 4;
    const int r0 = min(max(r - 4, 0), 56), kstart = min(max(j * 16 - 8, 0), 32);
    const int qc = j * 16 + li, wst = min(max(qc - 8, 0), 48);
    float kgv[32];
    bf16x8 qf[4];
    {
        float qv[32]; float ss = 0.f;
        const bf16* qp = P + (size_t)(qrow0 + li) * LDP0 + h * 128 + quad * 8;
#pragma unroll
        for (int ds = 0; ds < 4; ++ds) { const u32x4 u = *(const u32x4*)(qp + ds * 32);
#pragma unroll
            for (int e = 0; e < 4; ++e) { qv[ds * 8 + 2 * e] = bflo(u[e]); qv[ds * 8 + 2 * e + 1] = bfhi(u[e]); } }
#pragma unroll
        for (int e = 0; e < 32; ++e) ss += qv[e] * qv[e];
        ss = qsum4(ss);
        const float rn = (__builtin_amdgcn_rsqf(ss * (1.f / 128.f) + EPS)) * 0.08838834764831845f;
#pragma unroll
        for (int ds = 0; ds < 4; ++ds) { const f32x4 g0 = *(const f32x4*)(qg + ds * 32 + quad * 8), g1 = *(const f32x4*)(qg + ds * 32 + quad * 8 + 4);
            const f32x4 k0 = *(const f32x4*)(kg + ds * 32 + quad * 8), k1 = *(const f32x4*)(kg + ds * 32 + quad * 8 + 4);
#pragma unroll
            for (int e = 0; e < 4; ++e) { kgv[ds * 8 + e] = k0[e]; kgv[ds * 8 + 4 + e] = k1[e]; }
            u32x4 w;
            w.x = pk2(qv[ds * 8 + 0] * rn * g0[0], qv[ds * 8 + 1] * rn * g0[1]); w.y = pk2(qv[ds * 8 + 2] * rn * g0[2], qv[ds * 8 + 3] * rn * g0[3]);
            w.z = pk2(qv[ds * 8 + 4] * rn * g1[0], qv[ds * 8 + 5] * rn * g1[1]); w.w = pk2(qv[ds * 8 + 6] * rn * g1[2], qv[ds * 8 + 7] * rn * g1[3]);
            qf[ds] = __builtin_bit_cast(bf16x8, w); }
    }
    float mrun = -1e30f, lrun = 0.f;
    f32x4 O[8];
#pragma unroll
    for (int d = 0; d < 8; ++d) O[d] = (f32x4){0.f, 0.f, 0.f, 0.f};
    const int nloc = isctx ? 0 : 4;
    for (int ch = 0; ch < nloc + 4; ++ch) {
        const bool loc = ch < nloc;
        f32x4 S[4]; int tokb[4];
#pragma unroll
        for (int g4 = 0; g4 < 4; ++g4) {
            int tok0, kr = 0; const int g = g4 & 1;
            if (loc) { kr = r0 + ch * 2 + (g4 >> 1); tok0 = b * SEQ + kr * 64 + kstart + g * 16; }
            else { tok0 = MLAT + b * CTXL + (ch - nloc) * 64 + g4 * 16; }
            tokb[g4] = tok0;
            const bf16* kp = P + (size_t)(tok0 + li) * LDP0 + 1024 + h * 128 + quad * 8;
            float kv[32]; float ss = 0.f;
#pragma unroll
            for (int ds = 0; ds < 4; ++ds) { const u32x4 u = *(const u32x4*)(kp + ds * 32);
#pragma unroll
                for (int e = 0; e < 4; ++e) { kv[ds * 8 + 2 * e] = bflo(u[e]); kv[ds * 8 + 2 * e + 1] = bfhi(u[e]); } }
#pragma unroll
            for (int e = 0; e < 32; ++e) ss += kv[e] * kv[e];
            ss = qsum4(ss);
            const float rn = __builtin_amdgcn_rsqf(ss * (1.f / 128.f) + EPS);
            f32x4 s = (f32x4){0.f, 0.f, 0.f, 0.f};
#pragma unroll
            for (int ds = 0; ds < 4; ++ds) { u32x4 w;
                w.x = pk2(kv[ds * 8 + 0] * rn * kgv[ds * 8 + 0], kv[ds * 8 + 1] * rn * kgv[ds * 8 + 1]); w.y = pk2(kv[ds * 8 + 2] * rn * kgv[ds * 8 + 2], kv[ds * 8 + 3] * rn * kgv[ds * 8 + 3]);
                w.z = pk2(kv[ds * 8 + 4] * rn * kgv[ds * 8 + 4], kv[ds * 8 + 5] * rn * kgv[ds * 8 + 5]); w.w = pk2(kv[ds * 8 + 6] * rn * kgv[ds * 8 + 6], kv[ds * 8 + 7] * rn * kgv[ds * 8 + 7]);
                s = __builtin_amdgcn_mfma_f32_16x16x32_bf16(__builtin_bit_cast(bf16x8, w), qf[ds], s, 0, 0, 0); }
            if (loc) {
                const int drow = kr - r + 7;
#pragma unroll
                for (int e = 0; e < 4; ++e) { const int kc = kstart + g * 16 + quad * 4 + e; const bool ok = (kc >= wst) && (kc < wst + 16);
                    const int dcol = min(max(kc - qc, -15), 15) + 15;
                    const float bias = rpb[(h * 15 + drow) * 31 + dcol];
                    s[e] = ok ? s[e] + bias : -1e30f; }
            }
            S[g4] = s;
        }
        float mx = -1e30f;
#pragma unroll
        for (int g4 = 0; g4 < 4; ++g4)
#pragma unroll
            for (int e = 0; e < 4; ++e) mx = fmaxf(mx, S[g4][e]);
        mx = qmax4(mx);
        const float mnew = fmaxf(mrun, mx), alpha = __expf(mrun - mnew);
        float rs = 0.f;
#pragma unroll
        for (int g4 = 0; g4 < 4; ++g4)
#pragma unroll
            for (int e = 0; e < 4; ++e) { const float p = __expf(S[g4][e] - mnew); S[g4][e] = p; rs += p; }
        rs = qsum4(rs);
        lrun = lrun * alpha + rs; mrun = mnew;
#pragma unroll
        for (int d = 0; d < 8; ++d) O[d] *= alpha;
#pragma unroll
        for (int pr = 0; pr < 2; ++pr) {
            u32x4 w; w.x = pk2(S[2 * pr][0], S[2 * pr][1]); w.y = pk2(S[2 * pr][2], S[2 * pr][3]); w.z = pk2(S[2 * pr + 1][0], S[2 * pr + 1][1]); w.w = pk2(S[2 * pr + 1][2], S[2 * pr + 1][3]);
            const bf16x8 pf = __builtin_bit_cast(bf16x8, w);
            const bf16* v0 = Vt + (size_t)(h * 128 + li) * MTOT + tokb[2 * pr] + quad * 4;
            const bf16* v1 = Vt + (size_t)(h * 128 + li) * MTOT + tokb[2 * pr + 1] + quad * 4;
#pragma unroll
            for (int d = 0; d < 8; ++d) { const u32x2 lo = *(const u32x2*)(v0 + (size_t)d * 16 * MTOT), hi = *(const u32x2*)(v1 + (size_t)d * 16 * MTOT);
                u32x4 vv; vv.x = lo.x; vv.y = lo.y; vv.z = hi.x; vv.w = hi.y;
                O[d] = __builtin_amdgcn_mfma_f32_16x16x32_bf16(__builtin_bit_cast(bf16x8, vv), pf, O[d], 0, 0, 0); }
        }
    }
    const float inv = 1.f / lrun;
    bf16* yp = Y + (size_t)(qrow0 + li) * DM + h * 128 + quad * 4;
#pragma unroll
    for (int d = 0; d < 8; ++d) { u32x2 w; w.x = pk2(O[d][0] * inv, O[d][1] * inv); w.y = pk2(O[d][2] * inv, O[d][3] * inv); *(u32x2*)(yp + d * 16) = w; }
}

__device__ __forceinline__ void na_tile2(int wt, const bf16* P, const bf16* Vt, const float* qg, const float* kg, const float* rpb, bf16* Y, int lane) {
    const bool isctx = wt >= 8192;
    int b, h, r = 0, j = 0, qrow0;
    if (!isctx) { j = wt & 3; r = (wt >> 2) & 63; h = (wt >> 8) & 7; b = wt >> 11; qrow0 = b * SEQ + r * 64 + j * 16; }
    else { const int x = wt - 8192; h = (x >> 4) & 7; b = x >> 7; qrow0 = MLAT + b * CTXL + (x & 15) * 16; }
    const int li = lane & 15, quad = lane >> 4;
    const int r0 = min(max(r - 4, 0), 56), kstart = min(max(j * 16 - 8, 0), 32);
    const int qc = j * 16 + li, wst = min(max(qc - 8, 0), 48);
    bf16x8 qf[4];
    {
        float qv[32]; float ss = 0.f;
        const bf16* qp = P + (size_t)(qrow0 + li) * LDP0 + h * 128 + quad * 8;
#pragma unroll
        for (int ds = 0; ds < 4; ++ds) { const u32x4 u = *(const u32x4*)(qp + ds * 32);
#pragma unroll
            for (int e = 0; e < 4; ++e) { qv[ds * 8 + 2 * e] = bflo(u[e]); qv[ds * 8 + 2 * e + 1] = bfhi(u[e]); } }
#pragma unroll
        for (int e = 0; e < 32; ++e) ss += qv[e] * qv[e];
        ss = qsum4(ss);
        const float rn = (__builtin_amdgcn_rsqf(ss * (1.f / 128.f) + EPS)) * 0.08838834764831845f;
#pragma unroll
        for (int ds = 0; ds < 4; ++ds) { const f32x4 g0 = *(const f32x4*)(qg + ds * 32 + quad * 8) * *(const f32x4*)(kg + ds * 32 + quad * 8), g1 = *(const f32x4*)(qg + ds * 32 + quad * 8 + 4) * *(const f32x4*)(kg + ds * 32 + quad * 8 + 4);
            u32x4 w;
            w.x = pk2(qv[ds * 8 + 0] * rn * g0[0], qv[ds * 8 + 1] * rn * g0[1]); w.y = pk2(qv[ds * 8 + 2] * rn * g0[2], qv[ds * 8 + 3] * rn * g0[3]);
            w.z = pk2(qv[ds * 8 + 4] * rn * g1[0], qv[ds * 8 + 5] * rn * g1[1]); w.w = pk2(qv[ds * 8 + 6] * rn * g1[2], qv[ds * 8 + 7] * rn * g1[3]);
            qf[ds] = __builtin_bit_cast(bf16x8, w); }
    }
    float mrun = -1e30f, lrun = 0.f;
    f32x4 O[8];
#pragma unroll
    for (int d = 0; d < 8; ++d) O[d] = (f32x4){0.f, 0.f, 0.f, 0.f};
    const int nloc8 = isctx ? 0 : 8, nb = nloc8 + 8;
    const bf16* kbase = P + 1024 + h * 128 + quad * 8;
    const bf16* vbase = Vt + (((size_t)h * NTG + quad) * 128 + li) * 4;
    u32x4 KA[8], KB[8]; u32x2 VA[16];
#define NA_TOK0(blk) ((blk) < nloc8 ? (b * SEQ + (r0 + (blk)) * 64 + kstart) : (MLAT + b * CTXL + ((blk) - nloc8) * 32))
#define NA_LOADV(V_, blk) do { const int tok0_ = NA_TOK0(blk); \
        _Pragma("unroll") for (int db = 0; db < 8; ++db) { V_[2 * db] = *(const u32x2*)(vbase + (size_t)(tok0_ >> 2) * 512 + db * 64); V_[2 * db + 1] = *(const u32x2*)(vbase + (size_t)((tok0_ >> 2) + 4) * 512 + db * 64); } } while (0)
#define NA_LOAD(K_, B_, blk) do { const int tok0_ = NA_TOK0(blk); \
        _Pragma("unroll") for (int g = 0; g < 2; ++g) _Pragma("unroll") for (int ds = 0; ds < 4; ++ds) K_[g * 4 + ds] = *(const u32x4*)(kbase + (size_t)(tok0_ + g * 16 + li) * LDP0 + ds * 32); \
        } while (0)
#define NA_COMP(K_, V_, B_, blk) do { f32x4 s_[2]; float B_[8]; \
        if ((blk) < nloc8) { const float* rb_ = rpb + (h * 15 + (r0 + (blk) - r + 7)) * 31; \
            _Pragma("unroll") for (int g = 0; g < 2; ++g) _Pragma("unroll") for (int e = 0; e < 4; ++e) { const int kc_ = kstart + g * 16 + quad * 4 + e; B_[g * 4 + e] = rb_[min(max(kc_ - qc, -15), 15) + 15]; } } \
        _Pragma("unroll") for (int g = 0; g < 2; ++g) { float ss_ = 0.f; \
            _Pragma("unroll") for (int ds = 0; ds < 4; ++ds) _Pragma("unroll") for (int e = 0; e < 4; ++e) { const float lo_ = bflo(K_[g * 4 + ds][e]), hi_ = bfhi(K_[g * 4 + ds][e]); ss_ += lo_ * lo_ + hi_ * hi_; } \
            ss_ = qsum4(ss_); const float rn_ = __builtin_amdgcn_rsqf(ss_ * (1.f / 128.f) + EPS); \
            f32x4 acc_ = (f32x4){0.f, 0.f, 0.f, 0.f}; \
            _Pragma("unroll") for (int ds = 0; ds < 4; ++ds) acc_ = __builtin_amdgcn_mfma_f32_16x16x32_bf16(__builtin_bit_cast(bf16x8, K_[g * 4 + ds]), qf[ds], acc_, 0, 0, 0); \
            _Pragma("unroll") for (int e = 0; e < 4; ++e) acc_[e] *= __shfl(rn_, quad * 4 + e); \
            if ((blk) < nloc8) { _Pragma("unroll") for (int e = 0; e < 4; ++e) { const int kc_ = kstart + g * 16 + quad * 4 + e; acc_[e] = ((kc_ >= wst) && (kc_ < wst + 16)) ? acc_[e] + B_[g * 4 + e] : -1e30f; } } \
            s_[g] = acc_; } \
        float mx_ = fmaxf(fmaxf(fmaxf(s_[0][0], s_[0][1]), fmaxf(s_[0][2], s_[0][3])), fmaxf(fmaxf(s_[1][0], s_[1][1]), fmaxf(s_[1][2], s_[1][3]))); \
        mx_ = qmax4(mx_); const float mnew_ = fmaxf(mrun, mx_), alpha_ = __expf(mrun - mnew_); float rs_ = 0.f; \
        _Pragma("unroll") for (int g = 0; g < 2; ++g) _Pragma("unroll") for (int e = 0; e < 4; ++e) { const float p_ = __expf(s_[g][e] - mnew_); s_[g][e] = p_; rs_ += p_; } \
        rs_ = qsum4(rs_); lrun = lrun * alpha_ + rs_; mrun = mnew_; \
        u32x4 w_; w_.x = pk2(s_[0][0], s_[0][1]); w_.y = pk2(s_[0][2], s_[0][3]); w_.z = pk2(s_[1][0], s_[1][1]); w_.w = pk2(s_[1][2], s_[1][3]); \
        const bf16x8 pf_ = __builtin_bit_cast(bf16x8, w_); \
        _Pragma("unroll") for (int db = 0; db < 8; ++db) { u32x4 vv_; vv_.x = V_[2 * db].x; vv_.y = V_[2 * db].y; vv_.z = V_[2 * db + 1].x; vv_.w = V_[2 * db + 1].y; \
            O[db] = __builtin_amdgcn_mfma_f32_16x16x32_bf16(__builtin_bit_cast(bf16x8, vv_), pf_, O[db] * alpha_, 0, 0, 0); } } while (0)
    NA_LOAD(KA, BA, 0);
    for (int blk = 0; blk < nb; blk += 2) {
        NA_LOADV(VA, blk); NA_LOAD(KB, BB, blk + 1);
        NA_COMP(KA, VA, BA, blk);
        NA_LOADV(VA, blk + 1); if (blk + 2 < nb) NA_LOAD(KA, BA, blk + 2);
        NA_COMP(KB, VA, BB, blk + 1);
    }
#undef NA_TOK0
#undef NA_LOAD
#undef NA_LOADV
#undef NA_COMP
    const float inv = 1.f / lrun;
    bf16* yp = Y + (size_t)(qrow0 + li) * DM + h * 128 + quad * 4;
#pragma unroll
    for (int d = 0; d < 8; ++d) { u32x2 w; w.x = pk2(O[d][0] * inv, O[d][1] * inv); w.y = pk2(O[d][2] * inv, O[d][3] * inv); *(u32x2*)(yp + d * 16) = w; }
}

__device__ __forceinline__ int chain_row(int b, int dir, int ci, int s) {
    if (ci < 4) { int t = ci * 64 + s; if (dir) t = CTXL - 1 - t; return MLAT + b * CTXL + t; }
    int t = (ci - 4) * 64 + s; if (dir) t = SEQ - 1 - t; return b * SEQ + t;
}
__device__ __forceinline__ void st8f(LAS float* p, u32x4 u, float sc) {
    *(LAS f32x4*)p = (f32x4){bflo(u.x) * sc, bfhi(u.x) * sc, bflo(u.y) * sc, bfhi(u.y) * sc};
    *(LAS f32x4*)(p + 4) = (f32x4){bflo(u.z) * sc, bfhi(u.z) * sc, bflo(u.w) * sc, bfhi(u.w) * sc};
}
constexpr int CH_Q = 0, CH_K = 32768, CH_V = 65536, CH_O = 81920, CH_SC = 98304;

__device__ __forceinline__ void mlstm_chain(LAS unsigned char* lds, int c, const bf16* P, const float* G, const float* gate_bias, bf16* Hout) {
    const int vs = c & 3, dir = (c >> 2) & 1, h = (c >> 3) & 3, b = c >> 5;
    LAS float* q_s = (LAS float*)(lds + CH_Q); LAS float* k_s = (LAS float*)(lds + CH_K); LAS float* v_s = (LAS float*)(lds + CH_V);
    LAS float* o_s = (LAS float*)(lds + CH_O); LAS f32x4* sc_s = (LAS f32x4*)(lds + CH_SC);
    const int tid = threadIdx.x, lane = tid & 63, wave = tid >> 6, v = tid >> 3, kq = tid & 7;
    bf16* Hd = Hout + (size_t)dir * DIRSZ;
    const float gb_i = gate_bias[(2 * dir) * 4 + h], gb_f = gate_bias[(2 * dir + 1) * 4 + h];
    float C[16], nn[16];
#pragma unroll
    for (int e = 0; e < 16; ++e) { C[e] = 0.f; nn[e] = 0.f; }
    float mprev = 0.f;
    u32x4 rq[2], rk[2], rv; float gi = 0.f, gf = 0.f;
#define ML_LOAD(ci_) do { \
        _Pragma("unroll") for (int i = 0; i < 2; ++i) { const int idx = tid + NTHR * i, slot = idx >> 4, pc = idx & 15; const bf16* rp = P + (size_t)chain_row(b, dir, (ci_), slot) * LDP0; \
            rq[i] = *(const u32x4*)(rp + 3072 + h * 128 + pc * 8); rk[i] = *(const u32x4*)(rp + 3584 + h * 128 + pc * 8); } \
        { const int slot = tid >> 3, pc = tid & 7; rv = *(const u32x4*)(P + (size_t)chain_row(b, dir, (ci_), slot) * LDP0 + 4096 + h * 256 + vs * 64 + pc * 8); } \
        if (wave == 0) { const float* gp = G + (size_t)chain_row(b, dir, (ci_), lane) * 32; gi = gp[(2 * dir) * 4 + h]; gf = gp[(2 * dir + 1) * 4 + h]; } } while (0)
    ML_LOAD(0);
    for (int ci = 0; ci < 68; ++ci) {
#pragma unroll
        for (int i = 0; i < 2; ++i) { const int idx = tid + NTHR * i, slot = idx >> 4, pc = idx & 15; st8f(q_s + slot * 128 + pc * 8, rq[i], 0.08838834764831845f); st8f(k_s + slot * 128 + pc * 8, rk[i], 1.f); }
        { const int slot = tid >> 3, pc = tid & 7; st8f(v_s + slot * 64 + pc * 8, rv, 1.f); }
        if (wave == 0) {
            const float li_ = gi + gb_i, lf_ = logsigmoidf_(gf + gb_f);
            float F = lf_;
#pragma unroll
            for (int o = 1; o < 64; o <<= 1) { const float t = __shfl_up(F, o); if (lane >= o) F += t; }
            float pm = li_ - F;
#pragma unroll
            for (int o = 1; o < 64; o <<= 1) { const float t = __shfl_up(pm, o); if (lane >= o) pm = fmaxf(pm, t); }
            const float mt = F + fmaxf(mprev, pm);
            float mm1 = __shfl_up(mt, 1); if (lane == 0) mm1 = mprev;
            sc_s[lane] = (f32x4){__expf(lf_ + mm1 - mt), __expf(li_ - mt), __expf(-mt), 0.f};
            mprev = __shfl(mt, 63);
        }
        __syncthreads();
        if (ci + 1 < 68) ML_LOAD(ci + 1);
        for (int t = 0; t < 64; ++t) {
            const f32x4 scv = sc_s[t];
            const float fp = scv.x, ip = scv.y;
            const float iv = ip * v_s[t * 64 + v];
            float pn = 0.f, pd = 0.f;
#pragma unroll
            for (int jj = 0; jj < 4; ++jj) { const f32x4 kk = *(LAS f32x4*)(k_s + t * 128 + kq * 16 + jj * 4), qq = *(LAS f32x4*)(q_s + t * 128 + kq * 16 + jj * 4);
#pragma unroll
                for (int e = 0; e < 4; ++e) { C[jj * 4 + e] = fp * C[jj * 4 + e] + iv * kk[e]; nn[jj * 4 + e] = fp * nn[jj * 4 + e] + ip * kk[e]; pn += C[jj * 4 + e] * qq[e]; pd += nn[jj * 4 + e] * qq[e]; } }
            pn = sum8(pn); pd = sum8(pd);
            if (kq == 0) o_s[t * 64 + v] = pn * __builtin_amdgcn_rcpf(fmaxf(fabsf(pd), scv.z));
        }
        __syncthreads();
        { const int slot = tid >> 3, pc = tid & 7; const LAS float* op = o_s + slot * 64 + pc * 8; const f32x4 a0 = *(const LAS f32x4*)op, a1 = *(const LAS f32x4*)(op + 4);
          u32x4 w; w.x = pk2(a0[0], a0[1]); w.y = pk2(a0[2], a0[3]); w.z = pk2(a1[0], a1[1]); w.w = pk2(a1[2], a1[3]);
          *(u32x4*)(Hd + (size_t)chain_row(b, dir, ci, slot) * 1024 + h * 256 + vs * 64 + pc * 8) = w; }
    }
#undef ML_LOAD
    __syncthreads();
}

__device__ __forceinline__ void hgrn_chain(LAS unsigned char* lds, int c, const bf16* P, const float* lb_logits, bf16* Oout) {
    const int vs = c & 1, dir = (c >> 1) & 1, h = (c >> 2) & 7, b = c >> 5;
    LAS float* q_s = (LAS float*)(lds + CH_Q); LAS float* f_s = (LAS float*)(lds + CH_K); LAS float* v_s = (LAS float*)(lds + CH_V); LAS float* o_s = (LAS float*)(lds + CH_O);
    const int tid = threadIdx.x, v = tid >> 3, kq = tid & 7;
    bf16* Od = Oout + (size_t)dir * DIRSZ;
    float lbv[8];
    { const int pc = tid & 15;
#pragma unroll
      for (int e = 0; e < 8; ++e) { const float l0 = lb_logits[h * 128 + pc * 8 + e], l1 = lb_logits[1024 + h * 128 + pc * 8 + e]; const float mx = fmaxf(l0, l1), e0 = __expf(l0 - mx), e1 = __expf(l1 - mx);
          const float p0 = e0 / (e0 + e1), p1 = e1 / (e0 + e1); lbv[e] = (p0 + p1) - p0; } }
    float S[16];
#pragma unroll
    for (int e = 0; e < 16; ++e) S[e] = 0.f;
    u32x4 rq[2], rf[2], rv;
#define HG_LOAD(ci_) do { \
        _Pragma("unroll") for (int i = 0; i < 2; ++i) { const int idx = tid + NTHR * i, slot = idx >> 4, pc = idx & 15; const bf16* rp = P + (size_t)chain_row(b, dir, (ci_), slot) * LDP1; \
            rq[i] = *(const u32x4*)(rp + h * 128 + pc * 8); rf[i] = *(const u32x4*)(rp + 1024 + dir * 1024 + h * 128 + pc * 8); } \
        { const int slot = tid >> 3, pc = tid & 7; rv = *(const u32x4*)(P + (size_t)chain_row(b, dir, (ci_), slot) * LDP1 + 3072 + h * 128 + vs * 64 + pc * 8); } } while (0)
    HG_LOAD(0);
    for (int ci = 0; ci < 68; ++ci) {
#pragma unroll
        for (int i = 0; i < 2; ++i) { const int idx = tid + NTHR * i, slot = idx >> 4, pc = idx & 15;
            float qv[8] = {bflo(rq[i].x), bfhi(rq[i].x), bflo(rq[i].y), bfhi(rq[i].y), bflo(rq[i].z), bfhi(rq[i].z), bflo(rq[i].w), bfhi(rq[i].w)};
            float fv[8] = {bflo(rf[i].x), bfhi(rf[i].x), bflo(rf[i].y), bfhi(rf[i].y), bflo(rf[i].z), bfhi(rf[i].z), bflo(rf[i].w), bfhi(rf[i].w)};
#pragma unroll
            for (int e = 0; e < 8; ++e) { qv[e] = siluf_(qv[e]); fv[e] = lbv[e] + (1.f - lbv[e]) * sigmoidf_(fv[e]); }
            *(LAS f32x4*)(q_s + slot * 128 + pc * 8) = (f32x4){qv[0], qv[1], qv[2], qv[3]}; *(LAS f32x4*)(q_s + slot * 128 + pc * 8 + 4) = (f32x4){qv[4], qv[5], qv[6], qv[7]};
            *(LAS f32x4*)(f_s + slot * 128 + pc * 8) = (f32x4){fv[0], fv[1], fv[2], fv[3]}; *(LAS f32x4*)(f_s + slot * 128 + pc * 8 + 4) = (f32x4){fv[4], fv[5], fv[6], fv[7]}; }
        { const int slot = tid >> 3, pc = tid & 7;
          float vv[8] = {bflo(rv.x), bfhi(rv.x), bflo(rv.y), bfhi(rv.y), bflo(rv.z), bfhi(rv.z), bflo(rv.w), bfhi(rv.w)};
#pragma unroll
          for (int e = 0; e < 8; ++e) vv[e] = siluf_(vv[e]);
          *(LAS f32x4*)(v_s + slot * 64 + pc * 8) = (f32x4){vv[0], vv[1], vv[2], vv[3]}; *(LAS f32x4*)(v_s + slot * 64 + pc * 8 + 4) = (f32x4){vv[4], vv[5], vv[6], vv[7]}; }
        __syncthreads();
        if (ci + 1 < 68) HG_LOAD(ci + 1);
        for (int t = 0; t < 64; ++t) {
            const float vt = v_s[t * 64 + v];
            float po = 0.f;
#pragma unroll
            for (int jj = 0; jj < 4; ++jj) { const f32x4 ff = *(LAS f32x4*)(f_s + t * 128 + kq * 16 + jj * 4), qq = *(LAS f32x4*)(q_s + t * 128 + kq * 16 + jj * 4);
#pragma unroll
                for (int e = 0; e < 4; ++e) { S[jj * 4 + e] = ff[e] * S[jj * 4 + e] + (1.f - ff[e]) * vt; po += S[jj * 4 + e] * qq[e]; } }
            po = sum8(po);
            if (kq == 0) o_s[t * 64 + v] = po;
        }
        __syncthreads();
        { const int slot = tid >> 3, pc = tid & 7; const LAS float* op = o_s + slot * 64 + pc * 8; const f32x4 a0 = *(const LAS f32x4*)op, a1 = *(const LAS f32x4*)(op + 4);
          u32x4 w; w.x = pk2(a0[0], a0[1]); w.y = pk2(a0[2], a0[3]); w.z = pk2(a1[0], a1[1]); w.w = pk2(a1[2], a1[3]);
          *(u32x4*)(Od + (size_t)chain_row(b, dir, ci, slot) * 1024 + h * 128 + vs * 64 + pc * 8) = w; }
    }
#undef HG_LOAD
    __syncthreads();
}

__device__ __forceinline__ void ssd_chain(LAS unsigned char* lds, int c, const bf16* XBC, const float* G, const float* dt_bias, const float* a_log, bf16* Yout) {
    const int dir = c & 1, h = (c >> 1) & 15, b = c >> 5, grp = h >> 3;
    LAS float* c_s = (LAS float*)(lds + CH_Q); LAS float* b_s = (LAS float*)(lds + CH_K); LAS float* x_s = (LAS float*)(lds + CH_V); LAS float* o_s = (LAS float*)(lds + CH_O);
    LAS f32x2* sc_s = (LAS f32x2*)(lds + CH_SC);
    const int tid = threadIdx.x, lane = tid & 63, wave = tid >> 6, p = tid >> 3, kq = tid & 7;
    bf16* Yd = Yout + (size_t)dir * DIRSZ;
    const float dtb = dt_bias[dir * 16 + h], Aneg = -__expf(a_log[dir * 16 + h]);
    float S[16];
#pragma unroll
    for (int e = 0; e < 16; ++e) S[e] = 0.f;
    u32x4 rc[2], rb[2], rx; float gdt = 0.f;
#define SD_LOAD(ci_) do { \
        _Pragma("unroll") for (int i = 0; i < 2; ++i) { const int idx = tid + NTHR * i, slot = idx >> 4, pc = idx & 15; const bf16* rp = XBC + (size_t)chain_row(b, dir, (ci_), slot) * 1536; \
            rb[i] = *(const u32x4*)(rp + 1024 + grp * 128 + pc * 8); rc[i] = *(const u32x4*)(rp + 1280 + grp * 128 + pc * 8); } \
        { const int slot = tid >> 3, pc = tid & 7; rx = *(const u32x4*)(XBC + (size_t)chain_row(b, dir, (ci_), slot) * 1536 + h * 64 + pc * 8); } \
        if (wave == 0) gdt = G[(size_t)chain_row(b, dir, (ci_), lane) * 32 + dir * 16 + h]; } while (0)
    SD_LOAD(0);
    for (int ci = 0; ci < 68; ++ci) {
#pragma unroll
        for (int i = 0; i < 2; ++i) { const int idx = tid + NTHR * i, slot = idx >> 4, pc = idx & 15; st8f(c_s + slot * 128 + pc * 8, rc[i], 1.f); st8f(b_s + slot * 128 + pc * 8, rb[i], 1.f); }
        { const int slot = tid >> 3, pc = tid & 7; st8f(x_s + slot * 64 + pc * 8, rx, 1.f); }
        if (wave == 0) { const float dt = softplusf_(gdt + dtb); sc_s[lane] = (f32x2){__expf(dt * Aneg), dt}; }
        __syncthreads();
        if (ci + 1 < 68) SD_LOAD(ci + 1);
        for (int t = 0; t < 64; ++t) {
            const f32x2 scv = sc_s[t];
            const float da = scv.x, dx = scv.y * x_s[t * 64 + p];
            float py = 0.f;
#pragma unroll
            for (int jj = 0; jj < 4; ++jj) { const f32x4 bb = *(LAS f32x4*)(b_s + t * 128 + kq * 16 + jj * 4), cc = *(LAS f32x4*)(c_s + t * 128 + kq * 16 + jj * 4);
#pragma unroll
                for (int e = 0; e < 4; ++e) { S[jj * 4 + e] = da * S[jj * 4 + e] + dx * bb[e]; py += S[jj * 4 + e] * cc[e]; } }
            py = sum8(py);
            if (kq == 0) o_s[t * 64 + p] = py;
        }
        __syncthreads();
        { const int slot = tid >> 3, pc = tid & 7; const LAS float* op = o_s + slot * 64 + pc * 8; const f32x4 a0 = *(const LAS f32x4*)op, a1 = *(const LAS f32x4*)(op + 4);
          u32x4 w; w.x = pk2(a0[0], a0[1]); w.y = pk2(a0[2], a0[3]); w.z = pk2(a1[0], a1[1]); w.w = pk2(a1[2], a1[3]);
          *(u32x4*)(Yd + (size_t)chain_row(b, dir, ci, slot) * 1024 + h * 64 + pc * 8) = w; }
    }
#undef SD_LOAD
    __syncthreads();
}


constexpr int PQ = 136, PS = 72;
constexpr int L_QX = 0, L_KX = 17408, L_KUT = 34816, L_VT = 53248, L_PM = 64768, L_ST0 = 73984, L_ST1 = 95744, L_SC = 117504, L_LG = 121600, L_SEG = 155392;
constexpr int LGP = 132;
typedef LAS bf16* lbf;
__device__ __forceinline__ float bfe(const u32x4& u, int e) { const unsigned w = u[e >> 1]; return (e & 1) ? bfhi(w) : bflo(w); }
__device__ __forceinline__ unsigned short bfraw(const u32x4& u, int e) { const unsigned w = u[e >> 1]; return (unsigned short)((e & 1) ? (w >> 16) : (w & 0xffffu)); }
__device__ __forceinline__ bf16x8 ldfrag(const LAS bf16* p) { return *(const LAS bf16x8*)p; }
__device__ __forceinline__ u32x2 pack4(const f32x4& v) { u32x2 w; w.x = pk2(v[0], v[1]); w.y = pk2(v[2], v[3]); return w; }

template <class PF>
__device__ __forceinline__ void chunk_scores(const LAS bf16* kx, const LAS bf16* qx, LAS bf16* pm, int wave, int lane, PF pf) {
    const int sb = wave >> 1, li = lane & 15, quad = lane >> 4;
    bf16x8 af[4];
#pragma unroll
    for (int ks = 0; ks < 4; ++ks) af[ks] = ldfrag(kx + (sb * 16 + li) * PQ + ks * 32 + quad * 8);
#pragma unroll
    for (int tt = 0; tt < 2; ++tt) {
        const int tb = (wave & 1) * 2 + tt, t = tb * 16 + li, s0 = sb * 16 + quad * 4;
        f32x4 v = (f32x4){0.f, 0.f, 0.f, 0.f};
        if (sb <= tb) {
            f32x4 acc = (f32x4){0.f, 0.f, 0.f, 0.f};
#pragma unroll
            for (int ks = 0; ks < 4; ++ks) acc = __builtin_amdgcn_mfma_f32_16x16x32_bf16(af[ks], ldfrag(qx + (tb * 16 + li) * PQ + ks * 32 + quad * 8), acc, 0, 0, 0);
            const f32x4 r = pf(acc, s0, t);
#pragma unroll
            for (int i = 0; i < 4; ++i) v[i] = (s0 + i <= t) ? r[i] : 0.f;
        }
        *(LAS u32x2*)(pm + t * PS + s0) = pack4(v);
    }
}
__device__ __forceinline__ void out_block(const LAS bf16* vt, const LAS bf16* stt, const bf16x8 (&bp)[2], const bf16x8 (&bq)[4], int dvb, int li, int quad, f32x4& a1, f32x4& a2) {
    a1 = (f32x4){0.f, 0.f, 0.f, 0.f}; a2 = (f32x4){0.f, 0.f, 0.f, 0.f};
#pragma unroll
    for (int ks = 0; ks < 2; ++ks) a1 = __builtin_amdgcn_mfma_f32_16x16x32_bf16(ldfrag(vt + (dvb * 16 + li) * PS + ks * 32 + quad * 8), bp[ks], a1, 0, 0, 0);
#pragma unroll
    for (int ks = 0; ks < 4; ++ks) a2 = __builtin_amdgcn_mfma_f32_16x16x32_bf16(ldfrag(stt + (dvb * 16 + li) * PQ + ks * 32 + quad * 8), bq[ks], a2, 0, 0, 0);
}
template <class PF>
__device__ __forceinline__ void chunk_scores_frag(const LAS bf16* kx, const bf16x8 (&bq)[4], int tb, int li, int quad, bf16x8 (&bp)[2], PF pf) {
    const int t = tb * 16 + li;
#pragma unroll
    for (int sp = 0; sp < 2; ++sp) { u32x4 w;
#pragma unroll
        for (int hf = 0; hf < 2; ++hf) { const int sb = 2 * sp + hf, s0 = sb * 16 + quad * 4; f32x4 v = (f32x4){0.f, 0.f, 0.f, 0.f};
            if (sb <= tb) { f32x4 acc = (f32x4){0.f, 0.f, 0.f, 0.f};
#pragma unroll
                for (int ks = 0; ks < 4; ++ks) acc = __builtin_amdgcn_mfma_f32_16x16x32_bf16(ldfrag(kx + (sb * 16 + li) * PQ + ks * 32 + quad * 8), bq[ks], acc, 0, 0, 0);
                const f32x4 r = pf(acc, s0, t);
#pragma unroll
                for (int i = 0; i < 4; ++i) v[i] = (s0 + i <= t) ? r[i] : 0.f; }
            w[hf * 2] = pk2(v[0], v[1]); w[hf * 2 + 1] = pk2(v[2], v[3]); }
        bp[sp] = __builtin_bit_cast(bf16x8, w); }
}
__device__ __forceinline__ void out_block2(const LAS bf16* vt, const LAS bf16* stt, const bf16x8 (&bp)[2], const bf16x8 (&bq)[4], int dvb, int li, int quad, f32x4& a1, f32x4& a2) {
    a1 = (f32x4){0.f, 0.f, 0.f, 0.f}; a2 = (f32x4){0.f, 0.f, 0.f, 0.f};
#pragma unroll
    for (int sp = 0; sp < 2; ++sp) { const u32x2 lo = *(const LAS u32x2*)(vt + (dvb * 16 + li) * PS + sp * 32 + quad * 4), hi = *(const LAS u32x2*)(vt + (dvb * 16 + li) * PS + sp * 32 + 16 + quad * 4);
        u32x4 av; av.x = lo.x; av.y = lo.y; av.z = hi.x; av.w = hi.y;
        a1 = __builtin_amdgcn_mfma_f32_16x16x32_bf16(__builtin_bit_cast(bf16x8, av), bp[sp], a1, 0, 0, 0); }
#pragma unroll
    for (int ks = 0; ks < 4; ++ks) a2 = __builtin_amdgcn_mfma_f32_16x16x32_bf16(ldfrag(stt + (dvb * 16 + li) * PQ + ks * 32 + quad * 8), bq[ks], a2, 0, 0, 0);
}
template <int NDVB, class DF>
__device__ __forceinline__ void chunk_state(const LAS bf16* kut, const LAS bf16* vt, LAS bf16* sttw, f32x4 (&St)[NDVB], int wave, int lane, DF df) {
    const int li = lane & 15, quad = lane >> 4, dk0 = wave * 16 + quad * 4;
    bf16x8 ak[2];
#pragma unroll
    for (int ks = 0; ks < 2; ++ks) ak[ks] = ldfrag(kut + (wave * 16 + li) * PS + ks * 32 + quad * 8);
    const f32x4 dec = df(dk0);
#pragma unroll
    for (int dvb = 0; dvb < NDVB; ++dvb) {
        St[dvb] *= dec;
#pragma unroll
        for (int ks = 0; ks < 2; ++ks) St[dvb] = __builtin_amdgcn_mfma_f32_16x16x32_bf16(ak[ks], ldfrag(vt + (dvb * 16 + li) * PS + ks * 32 + quad * 8), St[dvb], 0, 0, 0);
        *(LAS u32x2*)(sttw + (dvb * 16 + li) * PQ + dk0) = pack4(St[dvb]);
    }
}

__device__ __forceinline__ void ssd_chain2(LAS unsigned char* lds, int c, const bf16* XBC, const float* G, const float* dt_bias, const float* a_log, bf16* Yout) {
    const int dir = c & 1, h = (c >> 1) & 15, b = c >> 5, grp = h >> 3;
    lbf qx = (lbf)(lds + L_QX), kx = (lbf)(lds + L_KX), kut = (lbf)(lds + L_KUT), vt = (lbf)(lds + L_VT), pm = (lbf)(lds + L_PM), st0 = (lbf)(lds + L_ST0), st1 = (lbf)(lds + L_ST1);
    LAS float* scl = (LAS float*)(lds + L_SC);
    const int tid = threadIdx.x, lane = tid & 63, wave = tid >> 6, li = lane & 15, quad = lane >> 4;
    bf16* Yd = Yout + (size_t)dir * DIRSZ;
    const float dtb = dt_bias[dir * 16 + h], Aneg = -__expf(a_log[dir * 16 + h]);
    f32x4 St[4];
#pragma unroll
    for (int e = 0; e < 4; ++e) St[e] = (f32x4){0.f, 0.f, 0.f, 0.f};
    for (int i = tid; i < 64 * PQ / 2; i += NTHR) ((LAS unsigned*)st0)[i] = 0u;
    u32x4 rc[2][2], rb[2][2], rx[2]; float gdt[2];
#define SD_LOAD(S_, ci_) do { \
        _Pragma("unroll") for (int i = 0; i < 2; ++i) { const int wi_ = wave + 8 * i, slot = (lane & 31) | ((wi_ & 1) << 5), pc = (lane >> 5) | ((wi_ >> 1) << 1); const bf16* rp = XBC + (size_t)chain_row(b, dir, (ci_), slot) * 1536; \
            rb[S_][i] = *(const u32x4*)(rp + 1024 + grp * 128 + pc * 8); rc[S_][i] = *(const u32x4*)(rp + 1280 + grp * 128 + pc * 8); } \
        { const int slot = (lane & 31) | ((wave & 1) << 5), pc = (lane >> 5) | ((wave >> 1) << 1); rx[S_] = *(const u32x4*)(XBC + (size_t)chain_row(b, dir, (ci_), slot) * 1536 + h * 64 + pc * 8); } \
        gdt[S_] = G[(size_t)chain_row(b, dir, (ci_), lane) * 32 + dir * 16 + h]; } while (0)
    SD_LOAD(0, 0);
    for (int c2 = 0; c2 < 34; ++c2) {
#pragma unroll
      for (int u = 0; u < 2; ++u) { const int ci = 2 * c2 + u;
        if (ci + 1 < 68) SD_LOAD(u ^ 1, ci + 1);
        const float dt = softplusf_(gdt[u] + dtb);
        const float acum = wave_scan_add(dt * Aneg);
        const float acl = lane63(acum);
        const float wv = __expf(acl - acum) * dt, dec = __expf(acl);
        if (wave == 0) { scl[lane] = acum; scl[64 + lane] = dt; scl[128 + lane] = __expf(acum); }
#pragma unroll
        for (int i = 0; i < 2; ++i) { const int wi_ = wave + 8 * i, slot = (lane & 31) | ((wi_ & 1) << 5), pc = (lane >> 5) | ((wi_ >> 1) << 1);
            *(LAS u32x4*)(qx + slot * PQ + pc * 8) = rc[u][i]; *(LAS u32x4*)(kx + slot * PQ + pc * 8) = rb[u][i];
            const float ws = __shfl(wv, slot);
#pragma unroll
            for (int e = 0; e < 8; ++e) kut[(pc * 8 + e) * PS + slot] = (bf16)f2bf(bfe(rb[u][i], e) * ws); }
        { const int slot = (lane & 31) | ((wave & 1) << 5), pc = (lane >> 5) | ((wave >> 1) << 1);
#pragma unroll
          for (int e = 0; e < 8; ++e) vt[(pc * 8 + e) * PS + slot] = bfraw(rx[u], e); }
        __syncthreads();
#define SCORE_FN_1 [=](const f32x4& acc, int s0, int t) { const float at = scl[t]; const f32x4 as = *(const LAS f32x4*)(scl + s0), ds = *(const LAS f32x4*)(scl + 64 + s0); \
            return (f32x4){acc[0] * __expf(at - as[0]) * ds[0], acc[1] * __expf(at - as[1]) * ds[1], acc[2] * __expf(at - as[2]) * ds[2], acc[3] * __expf(at - as[3]) * ds[3]}; }
        { const lbf stt = (ci & 1) ? st1 : st0; const int tb = wave >> 1, t = tb * 16 + li;
          bf16x8 bp[2], bq[4];
#pragma unroll
          for (int ks = 0; ks < 4; ++ks) bq[ks] = ldfrag(qx + t * PQ + ks * 32 + quad * 8);
          chunk_scores_frag(kx, bq, tb, li, quad, bp, SCORE_FN_1);
          const float ea = scl[128 + t]; bf16* yp = Yd + (size_t)chain_row(b, dir, ci, t) * 1024 + h * 64 + quad * 4;
#pragma unroll
          for (int d2 = 0; d2 < 2; ++d2) { const int dvb = (wave & 1) * 2 + d2; f32x4 a1, a2; out_block2(vt, stt, bp, bq, dvb, li, quad, a1, a2);
              *(u32x2*)(yp + dvb * 16) = pack4(a1 + ea * a2); } }
        chunk_state<4>(kut, vt, (ci & 1) ? st0 : st1, St, wave, lane, [=](int) { return (f32x4){dec, dec, dec, dec}; });
        __syncthreads();
      }
    }
#undef SD_LOAD
}

__device__ __forceinline__ void hgrn_chain2(LAS unsigned char* lds, int c, const bf16* P, const float* lb_logits, bf16* Oout) {
    const int vs = c & 1, dir = (c >> 1) & 1, h = (c >> 2) & 7, b = c >> 5;
    lbf qx = (lbf)(lds + L_QX), kx = (lbf)(lds + L_KX), kut = (lbf)(lds + L_KUT), vt = (lbf)(lds + L_VT), pm = (lbf)(lds + L_PM), st0 = (lbf)(lds + L_ST0), st1 = (lbf)(lds + L_ST1);
    LAS float* egl = (LAS float*)(lds + L_SC); LAS float* lg = (LAS float*)(lds + L_LG); LAS float* seg = (LAS float*)(lds + L_SEG);
    const int tid = threadIdx.x, lane = tid & 63, wave = tid >> 6, li = lane & 15, quad = lane >> 4;
    bf16* Od = Oout + (size_t)dir * DIRSZ;
    float lbv[2][8];
#pragma unroll
    for (int i = 0; i < 2; ++i) { const int wi_ = wave + 8 * i, pc = (lane >> 5) | ((wi_ >> 1) << 1);
#pragma unroll
      for (int e = 0; e < 8; ++e) { const float l0 = lb_logits[h * 128 + pc * 8 + e], l1 = lb_logits[1024 + h * 128 + pc * 8 + e]; const float mx = fmaxf(l0, l1), e0 = __expf(l0 - mx), e1 = __expf(l1 - mx);
          const float p0 = e0 / (e0 + e1), p1 = e1 / (e0 + e1); lbv[i][e] = (p0 + p1) - p0; } }
    f32x4 St[4];
#pragma unroll
    for (int e = 0; e < 4; ++e) St[e] = (f32x4){0.f, 0.f, 0.f, 0.f};
    for (int i = tid; i < 64 * PQ / 2; i += NTHR) ((LAS unsigned*)st0)[i] = 0u;
    u32x4 rq[2][2], rf[2][2], rv[2];
#define HG_LOAD(S_, ci_) do { \
        _Pragma("unroll") for (int i = 0; i < 2; ++i) { const int wi_ = wave + 8 * i, slot = (lane & 31) | ((wi_ & 1) << 5), pc = (lane >> 5) | ((wi_ >> 1) << 1); const bf16* rp = P + (size_t)chain_row(b, dir, (ci_), slot) * LDP1; \
            rq[S_][i] = *(const u32x4*)(rp + h * 128 + pc * 8); rf[S_][i] = *(const u32x4*)(rp + 1024 + dir * 1024 + h * 128 + pc * 8); } \
        { const int slot = (lane & 31) | ((wave & 1) << 5), pc = (lane >> 5) | ((wave >> 1) << 1); rv[S_] = *(const u32x4*)(P + (size_t)chain_row(b, dir, (ci_), slot) * LDP1 + 3072 + h * 128 + vs * 64 + pc * 8); } } while (0)
    HG_LOAD(0, 0);
    for (int c2 = 0; c2 < 34; ++c2) {
#pragma unroll
      for (int u = 0; u < 2; ++u) { const int ci = 2 * c2 + u;
        if (ci + 1 < 68) HG_LOAD(u ^ 1, ci + 1);
        float qs[2][8], kf[2][8];
#pragma unroll
        for (int i = 0; i < 2; ++i) { const int wi_ = wave + 8 * i, slot = (lane & 31) | ((wi_ & 1) << 5), pc = (lane >> 5) | ((wi_ >> 1) << 1); float lgv[8];
#pragma unroll
            for (int e = 0; e < 8; ++e) { qs[i][e] = siluf_(bfe(rq[u][i], e)); const float f = lbv[i][e] + (1.f - lbv[i][e]) * sigmoidf_(bfe(rf[u][i], e)); kf[i][e] = 1.f - f; lgv[e] = f; }
            const int pcs = pc ^ ((slot >> 4) & 3);
            *(LAS f32x4*)(lg + slot * LGP + pcs * 8) = (f32x4){lgv[0], lgv[1], lgv[2], lgv[3]}; *(LAS f32x4*)(lg + slot * LGP + pcs * 8 + 4) = (f32x4){lgv[4], lgv[5], lgv[6], lgv[7]}; }
        { const int slot = (lane & 31) | ((wave & 1) << 5), pc = (lane >> 5) | ((wave >> 1) << 1);
#pragma unroll
          for (int e = 0; e < 8; ++e) vt[(pc * 8 + e) * PS + slot] = (bf16)f2bf(siluf_(bfe(rv[u], e))); }
        __syncthreads();
        { const int dk = tid >> 2, sg = tid & 3, dkc = dk ^ (sg << 3); float pr[16]; float run = 1.f;
#pragma unroll
          for (int i = 0; i < 16; ++i) { run *= lg[(sg * 16 + i) * LGP + dkc]; pr[i] = run; }
          const float ta = dppmov<0x90, 0xF>(1.f, run), tb2 = dppmov<0x40, 0xF>(1.f, run), tc = dppmov<0x00, 0xF>(1.f, run);
          const float off = (sg >= 1 ? ta : 1.f) * (sg >= 2 ? tb2 : 1.f) * (sg >= 3 ? tc : 1.f);
#pragma unroll
          for (int i = 0; i < 16; ++i) lg[(sg * 16 + i) * LGP + dkc] = pr[i] * off;
          if (sg == 3) egl[dk] = run * off; }
        __syncthreads();
#pragma unroll
        for (int i = 0; i < 2; ++i) { const int wi_ = wave + 8 * i, slot = (lane & 31) | ((wi_ & 1) << 5), pc = (lane >> 5) | ((wi_ >> 1) << 1);
            float gv[8], gl[8];
            const int pcs = pc ^ ((slot >> 4) & 3);
#pragma unroll
            for (int hh = 0; hh < 2; ++hh) { const f32x4 l = *(const LAS f32x4*)(lg + slot * LGP + pcs * 8 + hh * 4), g4 = *(const LAS f32x4*)(egl + pc * 8 + hh * 4);
#pragma unroll
                for (int e = 0; e < 4; ++e) { gv[hh * 4 + e] = l[e]; gl[hh * 4 + e] = g4[e]; } }
            u32x4 wq, wk;
#pragma unroll
            for (int e = 0; e < 4; ++e) { const float r0 = __builtin_amdgcn_rcpf(gv[2 * e]), r1 = __builtin_amdgcn_rcpf(gv[2 * e + 1]);
                wq[e] = pk2(qs[i][2 * e] * gv[2 * e], qs[i][2 * e + 1] * gv[2 * e + 1]); wk[e] = pk2(kf[i][2 * e] * r0, kf[i][2 * e + 1] * r1);
                kf[i][2 * e] *= gl[2 * e] * r0; kf[i][2 * e + 1] *= gl[2 * e + 1] * r1; }
            *(LAS u32x4*)(qx + slot * PQ + pc * 8) = wq; *(LAS u32x4*)(kx + slot * PQ + pc * 8) = wk;
#pragma unroll
            for (int e = 0; e < 8; ++e) kut[(pc * 8 + e) * PS + slot] = (bf16)f2bf(kf[i][e]); }
        __syncthreads();
#define SCORE_FN_2 [=](const f32x4& acc, int, int) { return acc; }
        { const lbf stt = (ci & 1) ? st1 : st0; const int tb = wave >> 1, t = tb * 16 + li;
          bf16x8 bp[2], bq[4];
#pragma unroll
          for (int ks = 0; ks < 4; ++ks) bq[ks] = ldfrag(qx + t * PQ + ks * 32 + quad * 8);
          chunk_scores_frag(kx, bq, tb, li, quad, bp, SCORE_FN_2);
          bf16* yp = Od + (size_t)chain_row(b, dir, ci, t) * 1024 + h * 128 + vs * 64 + quad * 4;
#pragma unroll
          for (int d2 = 0; d2 < 2; ++d2) { const int dvb = (wave & 1) * 2 + d2; f32x4 a1, a2; out_block2(vt, stt, bp, bq, dvb, li, quad, a1, a2);
              *(u32x2*)(yp + dvb * 16) = pack4(a1 + a2); } }
        chunk_state<4>(kut, vt, (ci & 1) ? st0 : st1, St, wave, lane, [=](int dk0) { return *(const LAS f32x4*)(egl + dk0); });
        __syncthreads();
      }
    }
#undef HG_LOAD
}

__device__ __forceinline__ void mlstm_chain2(LAS unsigned char* lds, int c, const bf16* P, const float* G, const float* gate_bias, bf16* Hout) {
    const int vs = c & 3, dir = (c >> 2) & 1, h = (c >> 3) & 3, b = c >> 5;
    lbf qx = (lbf)(lds + L_QX), kx = (lbf)(lds + L_KX), kut = (lbf)(lds + L_KUT), vt = (lbf)(lds + L_VT), pm = (lbf)(lds + L_PM), st0 = (lbf)(lds + L_ST0), st1 = (lbf)(lds + L_ST1);
    LAS float* scl = (LAS float*)(lds + L_SC);
    const int tid = threadIdx.x, lane = tid & 63, wave = tid >> 6, li = lane & 15, quad = lane >> 4;
    bf16* Hd = Hout + (size_t)dir * DIRSZ;
    const float gb_i = gate_bias[(2 * dir) * 4 + h], gb_f = gate_bias[(2 * dir + 1) * 4 + h];
    f32x4 St[5];
#pragma unroll
    for (int e = 0; e < 5; ++e) St[e] = (f32x4){0.f, 0.f, 0.f, 0.f};
    for (int i = tid; i < 80 * PQ / 2; i += NTHR) ((LAS unsigned*)st0)[i] = 0u;
    for (int i = tid; i < 16 * PS; i += NTHR) vt[64 * PS + i] = (i < 64) ? (bf16)0x3F80u : (bf16)0u;
    float mprev = 0.f;
    u32x4 rq[2][2], rk[2][2], rv[2]; float gi[2], gf[2];
#define ML_LOAD(S_, ci_) do { \
        _Pragma("unroll") for (int i = 0; i < 2; ++i) { const int wi_ = wave + 8 * i, slot = (lane & 31) | ((wi_ & 1) << 5), pc = (lane >> 5) | ((wi_ >> 1) << 1); const bf16* rp = P + (size_t)chain_row(b, dir, (ci_), slot) * LDP0; \
            rq[S_][i] = *(const u32x4*)(rp + 3072 + h * 128 + pc * 8); rk[S_][i] = *(const u32x4*)(rp + 3584 + h * 128 + pc * 8); } \
        { const int slot = (lane & 31) | ((wave & 1) << 5), pc = (lane >> 5) | ((wave >> 1) << 1); rv[S_] = *(const u32x4*)(P + (size_t)chain_row(b, dir, (ci_), slot) * LDP0 + 4096 + h * 256 + vs * 64 + pc * 8); } \
        { const float* gp = G + (size_t)chain_row(b, dir, (ci_), lane) * 32; gi[S_] = gp[(2 * dir) * 4 + h]; gf[S_] = gp[(2 * dir + 1) * 4 + h]; } } while (0)
    ML_LOAD(0, 0);
    for (int c2 = 0; c2 < 34; ++c2) {
#pragma unroll
      for (int u = 0; u < 2; ++u) { const int ci = 2 * c2 + u;
        if (ci + 1 < 68) ML_LOAD(u ^ 1, ci + 1);
        const float li_ = gi[u] + gb_i, lf_ = logsigmoidf_(gf[u] + gb_f);
        const float F = wave_scan_add(lf_);
        const float pmx = wave_scan_max(li_ - F);
        const float mt = F + fmaxf(mprev, pmx);
        const float mnew = lane63(mt), F63 = lane63(F);
        const float wv = __expf(F63 - F + li_ - mnew), adec = __expf(F63 + mprev - mnew);
        if (wave == 0) { scl[lane] = F - mt; scl[64 + lane] = li_ - F; scl[128 + lane] = __expf(F + mprev - mt); scl[192 + lane] = __expf(-mt); }
        mprev = mnew;
#pragma unroll
        for (int i = 0; i < 2; ++i) { const int wi_ = wave + 8 * i, slot = (lane & 31) | ((wi_ & 1) << 5), pc = (lane >> 5) | ((wi_ >> 1) << 1);
            u32x4 wq;
#pragma unroll
            for (int e = 0; e < 4; ++e) wq[e] = pk2(bflo(rq[u][i][e]) * 0.08838834764831845f, bfhi(rq[u][i][e]) * 0.08838834764831845f);
            *(LAS u32x4*)(qx + slot * PQ + pc * 8) = wq; *(LAS u32x4*)(kx + slot * PQ + pc * 8) = rk[u][i];
            const float ws = __shfl(wv, slot);
#pragma unroll
            for (int e = 0; e < 8; ++e) kut[(pc * 8 + e) * PS + slot] = (bf16)f2bf(bfe(rk[u][i], e) * ws); }
        { const int slot = (lane & 31) | ((wave & 1) << 5), pc = (lane >> 5) | ((wave >> 1) << 1);
#pragma unroll
          for (int e = 0; e < 8; ++e) vt[(pc * 8 + e) * PS + slot] = bfraw(rv[u], e); }
        __syncthreads();
#define SCORE_FN_3 [=](const f32x4& acc, int s0, int t) { const float rt = scl[t]; const f32x4 cs = *(const LAS f32x4*)(scl + 64 + s0); \
            return (f32x4){acc[0] * __expf(rt + cs[0]), acc[1] * __expf(rt + cs[1]), acc[2] * __expf(rt + cs[2]), acc[3] * __expf(rt + cs[3])}; }
        { const lbf stt = (ci & 1) ? st1 : st0; const int tb = wave >> 1, t = tb * 16 + li;
          bf16x8 bp[2], bq[4];
#pragma unroll
          for (int ks = 0; ks < 4; ++ks) bq[ks] = ldfrag(qx + t * PQ + ks * 32 + quad * 8);
          chunk_scores_frag(kx, bq, tb, li, quad, bp, SCORE_FN_3);
          const float wi = scl[128 + t], em = scl[192 + t];
          f32x4 a1, a2; out_block2(vt, stt, bp, bq, 4, li, quad, a1, a2);
          const float den = __shfl(a1[0] + wi * a2[0], li);
          const float rden = __builtin_amdgcn_rcpf(fmaxf(fabsf(den), em));
          bf16* yp = Hd + (size_t)chain_row(b, dir, ci, t) * 1024 + h * 256 + vs * 64 + quad * 4;
#pragma unroll
          for (int d2 = 0; d2 < 2; ++d2) { const int dvb = (wave & 1) * 2 + d2; out_block2(vt, stt, bp, bq, dvb, li, quad, a1, a2);
              *(u32x2*)(yp + dvb * 16) = pack4((a1 + wi * a2) * rden); } }
        chunk_state<5>(kut, vt, (ci & 1) ? st0 : st1, St, wave, lane, [=](int) { return (f32x4){adec, adec, adec, adec}; });
        __syncthreads();
      }
    }
#undef ML_LOAD
}

__device__ __forceinline__ void unpack8(const u32x4& u, float* f) { f[0] = bflo(u.x); f[1] = bfhi(u.x); f[2] = bflo(u.y); f[3] = bfhi(u.y); f[4] = bflo(u.z); f[5] = bfhi(u.z); f[6] = bflo(u.w); f[7] = bfhi(u.w); }
__device__ __forceinline__ u32x4 pack8(const float* f) { u32x4 w; w.x = pk2(f[0], f[1]); w.y = pk2(f[2], f[3]); w.z = pk2(f[4], f[5]); w.w = pk2(f[6], f[7]); return w; }
__device__ __forceinline__ void phase_post0(const bf16* Hdir, const bf16* P, const float* ml_gain, bf16* Y) {
    const int lane = threadIdx.x & 63, wave = threadIdx.x >> 6, c0 = lane * 16;
    const int gw = blockIdx.x * NWAVES + wave, NGW = gridDim.x * NWAVES;
    float g[16];
#pragma unroll
    for (int q = 0; q < 4; ++q) { const f32x4 t = *(const f32x4*)(ml_gain + c0 + 4 * q); g[4 * q] = t[0]; g[4 * q + 1] = t[1]; g[4 * q + 2] = t[2]; g[4 * q + 3] = t[3]; }
    for (int row0 = gw; row0 < MTOT; row0 += 4 * NGW) {
        u32x4 hf[4][2], hb[4][2], og[4][2];
#pragma unroll
        for (int k = 0; k < 4; ++k) { const int row = row0 + k * NGW;
            if (row < MTOT) {
#pragma unroll
                for (int q = 0; q < 2; ++q) { hf[k][q] = *(const u32x4*)(Hdir + (size_t)row * 1024 + c0 + 8 * q); hb[k][q] = *(const u32x4*)(Hdir + DIRSZ + (size_t)row * 1024 + c0 + 8 * q);
                    og[k][q] = *(const u32x4*)(P + (size_t)row * LDP0 + 5120 + c0 + 8 * q); } } }
#pragma unroll
        for (int k = 0; k < 4; ++k) { const int row = row0 + k * NGW;
            if (row < MTOT) {
                float hv[16], t1[8], t2[8], ov[16]; float ss = 0.f;
#pragma unroll
                for (int q = 0; q < 2; ++q) { unpack8(hf[k][q], t1); unpack8(hb[k][q], t2); unpack8(og[k][q], ov + 8 * q);
#pragma unroll
                    for (int e = 0; e < 8; ++e) { hv[8 * q + e] = t1[e] + t2[e]; ss += hv[8 * q + e] * hv[8 * q + e]; } }
                ss = sum8(ss); ss += __shfl_xor(ss, 8);
                const float r = __builtin_amdgcn_rsqf(ss * (1.f / 256.f) + EPS);
#pragma unroll
                for (int e = 0; e < 16; ++e) hv[e] = hv[e] * r * g[e] * sigmoidf_(ov[e]);
                *(u32x4*)(Y + (size_t)row * DM + 1024 + c0) = pack8(hv); *(u32x4*)(Y + (size_t)row * DM + 1024 + c0 + 8) = pack8(hv + 8);
            } }
    }
}
__device__ __forceinline__ void phase_conv(const bf16* P, const float* conv_w, const float* conv_b, bf16* XBC) {
    const int NITEM = MTOT * 192, stride = gridDim.x * NTHR;
    for (int it0 = blockIdx.x * NTHR + threadIdx.x; it0 < NITEM; it0 += 2 * stride) {
        u32x4 u[2][5];
#pragma unroll
        for (int k = 0; k < 2; ++k) { const int it = it0 + k * stride;
            if (it < NITEM) { const int row = it / 192, c0 = (it % 192) * 8;
                int t, T, base;
                if (row < MLAT) { t = row & (SEQ - 1); T = SEQ; base = row - t; } else { t = (row - MLAT) & (CTXL - 1); T = CTXL; base = row - t; }
#pragma unroll
                for (int j = 0; j < 5; ++j) { const int tt = t + j - 2;
                    u[k][j] = (tt >= 0 && tt < T) ? *(const u32x4*)(P + (size_t)(base + tt) * LDP1 + 6144 + c0) : (u32x4){0u, 0u, 0u, 0u}; } } }
#pragma unroll
        for (int k = 0; k < 2; ++k) { const int it = it0 + k * stride;
            if (it < NITEM) { const int row = it / 192, c0 = (it % 192) * 8;
                float acc[8];
                { const f32x4 b0 = *(const f32x4*)(conv_b + c0), b1 = *(const f32x4*)(conv_b + c0 + 4);
#pragma unroll
                  for (int e = 0; e < 4; ++e) { acc[e] = b0[e]; acc[4 + e] = b1[e]; } }
#pragma unroll
                for (int j = 0; j < 5; ++j) { const u32x4 uu = u[k][j];
                    const f32x4 w0 = *(const f32x4*)(conv_w + j * 1536 + c0), w1 = *(const f32x4*)(conv_w + j * 1536 + c0 + 4);
                    acc[0] += w0[0] * bflo(uu.x); acc[1] += w0[1] * bfhi(uu.x); acc[2] += w0[2] * bflo(uu.y); acc[3] += w0[3] * bfhi(uu.y);
                    acc[4] += w1[0] * bflo(uu.z); acc[5] += w1[1] * bfhi(uu.z); acc[6] += w1[2] * bflo(uu.w); acc[7] += w1[3] * bfhi(uu.w); }
                u32x4 w; w.x = pk2(siluf_(acc[0]), siluf_(acc[1])); w.y = pk2(siluf_(acc[2]), siluf_(acc[3])); w.z = pk2(siluf_(acc[4]), siluf_(acc[5])); w.w = pk2(siluf_(acc[6]), siluf_(acc[7]));
                *(u32x4*)(XBC + (size_t)row * 1536 + c0) = w; } }
    }
}
__device__ __forceinline__ void phase_post1(const bf16* Odir, const bf16* Ydir, const bf16* P, const bf16* XBC, const float* hg_gain, const float* d_skip, const float* ssd_gain, bf16* Y) {
    const int lane = threadIdx.x & 63, wave = threadIdx.x >> 6, c0 = lane * 16;
    const int gw = blockIdx.x * NWAVES + wave, NGW = gridDim.x * NWAVES;
    float hg[16], sg[16];
#pragma unroll
    for (int q = 0; q < 4; ++q) { const f32x4 t = *(const f32x4*)(hg_gain + c0 + 4 * q), u = *(const f32x4*)(ssd_gain + c0 + 4 * q);
#pragma unroll
        for (int e = 0; e < 4; ++e) { hg[4 * q + e] = t[e]; sg[4 * q + e] = u[e]; } }
    const float ds = d_skip[c0 >> 6];
    for (int row = gw; row < MTOT; row += NGW) {
        u32x4 of[2], ob[2], og[2], yf[2], yb[2], xv[2], zv[2];
#pragma unroll
        for (int q = 0; q < 2; ++q) {
            of[q] = *(const u32x4*)(Odir + (size_t)row * 1024 + c0 + 8 * q); ob[q] = *(const u32x4*)(Odir + DIRSZ + (size_t)row * 1024 + c0 + 8 * q);
            og[q] = *(const u32x4*)(P + (size_t)row * LDP1 + 4096 + c0 + 8 * q);
            yf[q] = *(const u32x4*)(Ydir + (size_t)row * 1024 + c0 + 8 * q); yb[q] = *(const u32x4*)(Ydir + DIRSZ + (size_t)row * 1024 + c0 + 8 * q);
            xv[q] = *(const u32x4*)(XBC + (size_t)row * 1536 + c0 + 8 * q); zv[q] = *(const u32x4*)(P + (size_t)row * LDP1 + 5120 + c0 + 8 * q); }
        { float hv[16], t1[8], t2[8], ov[16]; float ss = 0.f;
#pragma unroll
          for (int q = 0; q < 2; ++q) { unpack8(of[q], t1); unpack8(ob[q], t2); unpack8(og[q], ov + 8 * q);
#pragma unroll
              for (int e = 0; e < 8; ++e) { hv[8 * q + e] = t1[e] + t2[e]; ss += hv[8 * q + e] * hv[8 * q + e]; } }
          ss = sum8(ss);
          const float r = __builtin_amdgcn_rsqf(ss * (1.f / 128.f) + EPS);
#pragma unroll
          for (int e = 0; e < 16; ++e) hv[e] = hv[e] * r * hg[e] * siluf_(ov[e]);
          *(u32x4*)(Y + (size_t)row * DM + c0) = pack8(hv); *(u32x4*)(Y + (size_t)row * DM + c0 + 8) = pack8(hv + 8); }
        { float yv[16], t1[8], t2[8], t3[8], t4[8]; float ss = 0.f;
#pragma unroll
          for (int q = 0; q < 2; ++q) { unpack8(yf[q], t1); unpack8(yb[q], t2); unpack8(xv[q], t3); unpack8(zv[q], t4);
#pragma unroll
              for (int e = 0; e < 8; ++e) { const float y = (t1[e] + t2[e] + ds * t3[e]) * siluf_(t4[e]); yv[8 * q + e] = y; ss += y * y; } }
          ss = sum8(ss); ss += __shfl_xor(ss, 8); ss += __shfl_xor(ss, 16);
          const float r = __builtin_amdgcn_rsqf(ss * (1.f / 512.f) + EPS);
#pragma unroll
          for (int e = 0; e < 16; ++e) yv[e] = yv[e] * r * sg[e];
          *(u32x4*)(Y + (size_t)row * DM + 1024 + c0) = pack8(yv); *(u32x4*)(Y + (size_t)row * DM + 1024 + c0 + 8) = pack8(yv + 8); }
    }
}

#define XB_TMO      128
#define XB_XCNT(j)  (256  + 64 * (j))
#define XB_XSUB(j)  (1280 + 64 * (j))
#define XB_XGEN(j)  (2304 + 64 * (j))
#define XB_TOP      3328
#define XB_TOPGEN   3392
#define XCD_BAR_WORDS 3456
#define XB_SPIN_CAP (1u << 18)

__device__ __forceinline__ unsigned xb_ld(unsigned* p)              { return __hip_atomic_load(p, __ATOMIC_RELAXED, __HIP_MEMORY_SCOPE_AGENT); }
__device__ __forceinline__ unsigned xb_add(unsigned* p, unsigned v) { return __hip_atomic_fetch_add(p, v, __ATOMIC_RELAXED, __HIP_MEMORY_SCOPE_AGENT); }
__device__ __forceinline__ unsigned xb_xcc_id() { return (unsigned)__builtin_amdgcn_s_getreg((3 << 11) | 20) & 0xFu; }
#define XB_SPIN(cond, bar) do { unsigned _sp = 0; while (cond) { __builtin_amdgcn_s_sleep(1); \
    if ((++_sp & 255u) == 0u) { if (xb_ld(&(bar)[XB_TMO])) break; if (_sp > XB_SPIN_CAP) { atomicAdd(&(bar)[XB_TMO], 1u); break; } } } } while (0)

struct XcdBarrier {
    unsigned* bar; unsigned x;
    volatile LAS unsigned* st;
};

__device__ __forceinline__ XcdBarrier xcd_barrier_post(unsigned* bar, volatile LAS unsigned* st) {
    XcdBarrier b; b.bar = bar; b.x = xb_xcc_id(); b.st = st;
    if (threadIdx.x == 0) (void)xb_add(&bar[XB_XCNT(b.x)], 1u);
    return b;
}
__device__ __forceinline__ void xcd_barrier_complete(unsigned* bar, unsigned x, unsigned& nloc, unsigned& nx) {
    const unsigned G = gridDim.x * gridDim.y * gridDim.z;
    unsigned sum, cnt, mine, sp = 0u;
    for (;;) {
        sum = 0u; cnt = 0u; mine = 0u;
#pragma unroll
        for (unsigned j = 0; j < 16; ++j) { const unsigned c = xb_ld(&bar[XB_XCNT(j)]); sum += c; cnt += (c > 0u) ? 1u : 0u; mine = (j == x) ? c : mine; }
        if (sum == G) break;
        __builtin_amdgcn_s_sleep(1);
        if ((++sp & 255u) == 0u) { if (xb_ld(&bar[XB_TMO])) break; if (sp > XB_SPIN_CAP) { atomicAdd(&bar[XB_TMO], 1u); break; } }
    }
    nloc = mine > 0u ? mine : 1u; nx = cnt > 0u ? cnt : 1u;
}

__device__ __forceinline__ void xcd_barrier(const XcdBarrier& b) {
    asm volatile("s_waitcnt vmcnt(0)" ::: "memory");
    __syncthreads();
    if (threadIdx.x == 0) {
        unsigned* bar = b.bar;
        __builtin_amdgcn_s_waitcnt(0);
        unsigned nloc = b.st[0], nx = b.st[1];
        if (nloc == 0u) { xcd_barrier_complete(bar, b.x, nloc, nx); b.st[0] = nloc; b.st[1] = nx; }
        const unsigned old = xb_add(&bar[XB_XSUB(b.x)], 1u);
        const unsigned gen = old / nloc;
        if (old + 1u == (gen + 1u) * nloc) {
            __builtin_amdgcn_fence(__ATOMIC_RELEASE, "agent");
            asm volatile("s_waitcnt vmcnt(0)" ::: "memory");
            const unsigned og = xb_add(&bar[XB_TOP], 1u);
            const unsigned tg = og / nx;
            if (og + 1u == (tg + 1u) * nx) xb_add(&bar[XB_TOPGEN], 1u);
            else XB_SPIN(xb_ld(&bar[XB_TOPGEN]) == tg, bar);
            __builtin_amdgcn_fence(__ATOMIC_ACQUIRE, "agent");
            xb_add(&bar[XB_XGEN(b.x)], 1u);
            asm volatile("s_waitcnt vmcnt(0)" ::: "memory");
        } else {
            XB_SPIN(xb_ld(&bar[XB_XGEN(b.x)]) == gen, bar);
            __builtin_amdgcn_fence(__ATOMIC_ACQUIRE, "agent");
            asm volatile("s_waitcnt vmcnt(0)" ::: "memory");
        }
    }
    __syncthreads();
}

#ifndef CHUNK_SSD
#define CHUNK_SSD 1
#endif
#ifndef CHUNK_HG
#define CHUNK_HG 1
#endif
#ifndef CHUNK_ML
#define CHUNK_ML 1
#endif
#if CHUNK_SSD
#define SSD_CHAIN ssd_chain2
#else
#define SSD_CHAIN ssd_chain
#endif
#if CHUNK_HG
#define HGRN_CHAIN hgrn_chain2
#else
#define HGRN_CHAIN hgrn_chain
#endif
#if CHUNK_ML
#define MLSTM_CHAIN mlstm_chain2
#else
#define MLSTM_CHAIN mlstm_chain
#endif
#ifndef PROBE_ML
#define PROBE_ML 1
#endif
#ifndef PROBE_NA
#define PROBE_NA 1
#endif
#ifndef PROBE_SYNCS
#define PROBE_SYNCS 0
#endif
#ifndef PROBE_CONV_IN_P12
#define PROBE_CONV_IN_P12 1
#endif
#ifndef PROBE_MASK
#define PROBE_MASK 0
#endif
#define REP(k) _Pragma("unroll 1") for (int rep_ = 0; rep_ < ((((PROBE_MASK) >> (k)) & 1) ? 2 : 1); ++rep_)
constexpr int NPHASE = 18;
struct SkipVOrder : pg8::StaticOrder {
    __device__ bool next(int i, pg8::Unit& u) const { const bool ok = pg8::StaticOrder::next(i, u); if (ok && u.pn >= 8) u.pn += 4; return ok; }
};
struct SplitKOrder {
    int G, c;
    __device__ bool next(int i, pg8::Unit& u) const { const int L = i * G + c; if (L >= 128) return false; u.ks = L & 3; u.pn = (L >> 2) & 7; u.pm = L >> 5; return true; }
    __device__ __forceinline__ void a_ready(const pg8::Unit&) const {}
    __device__ __forceinline__ void done(const pg8::Unit&) const {}
};
struct EpiPart {
    static constexpr bool PERM = false, AFTER_DRAIN = false;
    float* part;
    __device__ __forceinline__ void operator()(const f32x4 (&acc)[2][2][4][2], const pg8::Unit& u, int wr, int wc, int fr, int fq) const {
        float* base = part + (size_t)u.ks * MCTX * DM + (size_t)(u.pm * 256 + wr * 64 + fr) * DM + u.pn * 256 + wc * 32 + 4 * fq;
#pragma unroll
        for (int ai = 0; ai < 2; ++ai)
#pragma unroll
            for (int m = 0; m < 4; ++m)
#pragma unroll
                for (int bj = 0; bj < 2; ++bj)
#pragma unroll
                    for (int n = 0; n < 2; ++n) *(f32x4*)(base + (size_t)(ai * 128 + m * 16) * DM + bj * 128 + n * 16) = acc[ai][bj][m][n];
    }
};
struct Args { const float* in[31]; float* out; unsigned char* ws; int ph_lo, ph_hi; };

__global__ void __launch_bounds__(NTHR, 2) fwd_kernel(Args a) {
    extern __shared__ __attribute__((aligned(16))) unsigned char lds_raw[];
    LAS unsigned char* lds = (LAS unsigned char*)lds_raw;
    cg::grid_group grid = cg::this_grid();
    unsigned char* ws = a.ws;
    float* MOD = (float*)(ws + WS_MOD);
    bf16* WIN = (bf16*)(ws + WS_WIN); bf16* WOUT = (bf16*)(ws + WS_WOUT); bf16* W13 = (bf16*)(ws + WS_W13); bf16* W2 = (bf16*)(ws + WS_W2);
    bf16* A = (bf16*)(ws + WS_A); bf16* P = (bf16*)(ws + WS_P); bf16* HB = (bf16*)(ws + WS_P); float* G = (float*)(ws + WS_G); bf16* Y = (bf16*)(ws + WS_Y);
    bf16* VT = (bf16*)(ws + WS_VT); bf16* XBC = (bf16*)(ws + WS_VT); bf16* DIRA = (bf16*)(ws + WS_A); bf16* DIRB = (bf16*)(ws + WS_DIRB); float* XC = (float*)(ws + WS_XC); float* PART = (float*)(ws + WS_PART); bf16* XB = (bf16*)(ws + WS_XB);
    const int lo = a.ph_lo, hi = a.ph_hi;
    volatile LAS unsigned* bst = (volatile LAS unsigned*)(lds + LDS_BYTES - 16);
    if (threadIdx.x < 4) bst[threadIdx.x] = 0u;
    __syncthreads();
    XcdBarrier xbar = xcd_barrier_post((unsigned*)(ws + WS_BAR), bst);
    if (lo < 0) grid.sync();
    const int wave = threadIdx.x >> 6, lane = threadIdx.x & 63;
    const int GSZ = gridDim.x, bid = blockIdx.x;
#define IN(k) (lo <= (k) && (k) < hi)
#define SEAM(k) do { if (IN(k) && IN((k) + 1)) xcd_barrier(xbar); } while (0)

    if (IN(0)) REP(0) {
        mod_gemv(lds, a.in[1], a.in[3], a.in[5], a.in[6], a.in[17], a.in[18], MOD, 0, 384 + 128, bid, GSZ);
        convert_weights(lds, ws, a.in[7], EVEN_IN, a.in[13], a.in[14], a.in[15], a.in[16], 3, bid, GSZ);
    }
    SEAM(0);
    if (IN(1)) REP(1) phase_modulate<false>(a.in[0], a.in[2], MOD, 0, 1, A, MTOT);
    SEAM(1);
    if (IN(2)) REP(2) {
        { pg8::Gemm g{A, WIN, MTOT, 6400, DM}; SkipVOrder S; S.init(MTOT, 6400 - 1024, GSZ, bid); EpiProj E{P, LDP0, 24, G, 16};
          pg8::gemm_phase<EpiProj, SkipVOrder, true, true>(lds, g, S, E); }
        { pg8::Gemm g{WIN + (size_t)2048 * DM, A, 1024, MTOT, DM}; pg8::StaticOrder S; S.init(1024, MTOT, GSZ, GSZ - 1 - bid); EpiBf E{VT, MTOT};
          pg8::gemm_phase<EpiBf, pg8::StaticOrder, true, true>(lds, g, S, E); }
        if (GSZ == 256) { if (bid >= 148 && bid < 240) convert_weights(lds, ws, a.in[7], EVEN_IN, a.in[13], a.in[14], a.in[15], a.in[16], 4, bid - 148, 92); }
        else convert_weights(lds, ws, a.in[7], EVEN_IN, a.in[13], a.in[14], a.in[15], a.in[16], 4, bid, GSZ);
    }
    SEAM(2);
    if (IN(3)) REP(3) {
        const int NCH = GSZ >= 256 ? 128 : GSZ / 2;
        unsigned* qctr = (unsigned*)(ws + WS_BAR) + 3584;
#define NA_QUEUE() for (;;) { unsigned wt = 0; if (lane == 0) wt = __hip_atomic_fetch_add(qctr, 1u, __ATOMIC_RELAXED, __HIP_MEMORY_SCOPE_AGENT); \
            wt = (unsigned)__builtin_amdgcn_readfirstlane((int)wt); if (wt >= 8192u + 512u) break; na_tile2((int)wt, P, VT, a.in[8], a.in[9], a.in[10], Y, lane); }
        if (bid < NCH) { for (int c = bid; c < 128; c += NCH) MLSTM_CHAIN(lds, c, P, G, a.in[11], DIRA); NA_QUEUE(); }
        else { NA_QUEUE(); }
    }
    SEAM(3);
    if (IN(4)) REP(4) phase_post0(DIRA, P, a.in[12], Y);
    SEAM(4);
    if (IN(5)) REP(5) {
        { pg8::Gemm g{Y, WOUT, MLAT, DM, DM}; pg8::StaticOrder S; S.init(MLAT, DM, GSZ, bid); EpiRes<false, true> E{a.in[0], XB, MOD + 2 * DM};
          pg8::gemm_phase<EpiRes<false, true>, pg8::StaticOrder, true, true>(lds, g, S, E); }
        { pg8::Gemm g{Y + (size_t)MLAT * DM, WOUT, MCTX, DM, DM / 4, DM}; SplitKOrder S{GSZ, bid}; EpiPart E{PART};
          pg8::gemm_phase<EpiPart, SplitKOrder, true, true>(lds, g, S, E); }
        if (GSZ == 256) { if (bid >= 128) convert_weights(lds, ws, a.in[7], EVEN_IN, a.in[13], a.in[14], a.in[15], a.in[16], 8, bid - 128, 128); }
        else convert_weights(lds, ws, a.in[7], EVEN_IN, a.in[13], a.in[14], a.in[15], a.in[16], 8, bid, GSZ); }
    SEAM(5);
    if (IN(6)) REP(6) phase_modulate<true>(XB, XC, MOD, 3, 4, A, MTOT, PART, a.in[2], MOD + 4 * NMODC + 2 * DM, XC);
    SEAM(6);
    if (IN(7)) REP(7) { pg8::Gemm g{A, W13, MTOT, 2 * FFH, DM}; pg8::StaticOrder S; S.init(MTOT, 2 * FFH, GSZ, bid); EpiSwiglu E{HB, FFH};
        pg8::gemm_phase<EpiSwiglu, pg8::StaticOrder, true, true>(lds, g, S, E);
        if (GSZ == 256) { if (bid >= 176) convert_weights(lds, ws, a.in[7], EVEN_IN, a.in[13], a.in[14], a.in[15], a.in[16], 16, bid - 176, 80); }
        else convert_weights(lds, ws, a.in[7], EVEN_IN, a.in[13], a.in[14], a.in[15], a.in[16], 16, bid, GSZ); }
    SEAM(7);
    if (IN(8)) REP(8) {
        { pg8::Gemm g{HB, W2, MLAT, DM, FFH}; pg8::StaticOrder S; S.init(MLAT, DM, GSZ, bid); EpiRes<true, true> E{XB, XB, MOD + 5 * DM};
          pg8::gemm_phase<EpiRes<true, true>, pg8::StaticOrder, true, true>(lds, g, S, E); }
        if (bid < 128 || GSZ < 256) { pg8::Gemm g{HB + (size_t)MLAT * FFH, W2, MCTX, DM, FFH / 4, FFH}; SplitKOrder S{GSZ, bid}; EpiPart E{PART};
          pg8::gemm_phase<EpiPart, SplitKOrder, true, true>(lds, g, S, E); }
        if (GSZ < 256) convert_weights(lds, ws, a.in[19], ODD_IN, a.in[27], a.in[28], a.in[29], a.in[30], 1, bid, GSZ);
        else if (bid >= 128) convert_weights(lds, ws, a.in[19], ODD_IN, a.in[27], a.in[28], a.in[29], a.in[30], 1, bid - 128, GSZ - 128); }
    SEAM(8);
    if (IN(9)) REP(9) {
        phase_modulate<true>(XB, XC, MOD + 5 * NMODC, 0, 1, A, MTOT, PART, XC, MOD + 4 * NMODC + 5 * DM, XC);
        if (!PROBE_CONV_IN_P12) convert_weights(lds, ws, a.in[19], ODD_IN, a.in[27], a.in[28], a.in[29], a.in[30], 30, bid, GSZ);
    }
    SEAM(9);
    if (IN(10)) REP(10) { pg8::Gemm g{A, WIN, MTOT, 7936, DM}; pg8::StaticOrder S; S.init(MTOT, 7936, GSZ, bid); EpiProj E{P, LDP1, 30, G, 32};
        pg8::gemm_phase<EpiProj, pg8::StaticOrder, true, true>(lds, g, S, E);
        const int nlast = (MTOT / 256) * 31 - ((MTOT / 256) * 31 / GSZ) * GSZ;
        if (nlast > 0 && nlast < GSZ) { if (bid >= nlast) mod_gemv(lds, a.in[1], a.in[3], a.in[5], a.in[6], a.in[17], a.in[18], MOD, 384 + 128, 768, bid - nlast, GSZ - nlast); }
        else mod_gemv(lds, a.in[1], a.in[3], a.in[5], a.in[6], a.in[17], a.in[18], MOD, 384 + 128, 768, bid, GSZ); }
    SEAM(10);
    if (IN(11)) REP(11) phase_conv(P, a.in[21], a.in[22], XBC);
    SEAM(11);
    if (IN(12)) REP(12) {
        const int NCH = GSZ >= 256 ? 128 : GSZ / 2;
        if (bid < NCH) { for (int c = bid; c < 128; c += NCH) HGRN_CHAIN(lds, c, P, a.in[4], DIRA); }
        else { for (int c = bid - NCH; c < 128; c += GSZ - NCH) SSD_CHAIN(lds, c, XBC, G, a.in[23], a.in[24], DIRB);
            __syncthreads();
            if (PROBE_CONV_IN_P12) convert_weights(lds, ws, a.in[19], ODD_IN, a.in[27], a.in[28], a.in[29], a.in[30], 30, bid - NCH, GSZ - NCH); }
    }
    SEAM(12);
    if (IN(13)) REP(13) phase_post1(DIRA, DIRB, P, XBC, a.in[20], a.in[25], a.in[26], Y);
    SEAM(13);
    if (IN(14)) REP(14) { pg8::Gemm g{Y, WOUT, MLAT, DM, DM}; pg8::StaticOrder S; S.init(MLAT, DM, GSZ, bid); EpiRes<true, true> E{XB, XB, MOD + 5 * NMODC + 2 * DM};
        pg8::gemm_phase<EpiRes<true, true>, pg8::StaticOrder, true, true>(lds, g, S, E); }
    SEAM(14);
    if (IN(15)) REP(15) phase_modulate<true>(XB, XC, MOD + 5 * NMODC, 3, 4, A, MLAT);
    SEAM(15);
    if (IN(16)) REP(16) { pg8::Gemm g{A, W13, MLAT, 2 * FFH, DM}; pg8::StaticOrder S; S.init(MLAT, 2 * FFH, GSZ, bid); EpiSwiglu E{HB, FFH};
        pg8::gemm_phase<EpiSwiglu, pg8::StaticOrder, true, true>(lds, g, S, E); }
    SEAM(16);
    if (IN(17)) REP(17) { pg8::Gemm g{HB, W2, MLAT, DM, FFH}; pg8::StaticOrder S; S.init(MLAT, DM, GSZ, bid); EpiRes<true, false> E{XB, a.out, MOD + 5 * NMODC + 5 * DM};
        pg8::gemm_phase<EpiRes<true, false>, pg8::StaticOrder, true, true>(lds, g, S, E); }
#undef IN
#undef SEAM
}

#ifndef MK_N_LAUNCHES
#define MK_N_LAUNCHES 1
#endif
extern "C" void kernel_launch(void* const* d_in, const int* in_sizes, int n_in, void* d_out, int out_size, void* d_ws, size_t ws_size, hipStream_t stream) {
    static int grid = 0;
    if (grid == 0) {
        if (n_in != 31 || out_size != MLAT * DM || ws_size < WS_END) { fprintf(stderr, "kernel_launch: unexpected shapes: n_in %d out %d ws %zu (need %zu)\n", n_in, out_size, ws_size, (size_t)WS_END); grid = -1; return; }
        int dev = 0, cus = 0, per_cu = 0;
        hipGetDevice(&dev); hipDeviceGetAttribute(&cus, hipDeviceAttributeMultiprocessorCount, dev);
        if (hipFuncSetAttribute((const void*)fwd_kernel, hipFuncAttributeMaxDynamicSharedMemorySize, LDS_BYTES) != hipSuccess) { fprintf(stderr, "kernel_launch: hipFuncSetAttribute failed\n"); grid = -1; return; }
        if (hipOccupancyMaxActiveBlocksPerMultiprocessor(&per_cu, (const void*)fwd_kernel, NTHR, LDS_BYTES) != hipSuccess || per_cu < 1) { fprintf(stderr, "kernel_launch: occupancy query says %d\n", per_cu); per_cu = 1; }
        (void)hipGetLastError();
        grid = cus * 1;
        if (grid > 256) grid = 256;
    }
    if (grid < 0) return;
    if (hipMemsetAsync((char*)d_ws + WS_BAR, 0, BAR_BYTES, stream) != hipSuccess) { fprintf(stderr, "kernel_launch: memset failed\n"); return; }
    Args a{};
    for (int i = 0; i < 31; ++i) a.in[i] = (const float*)d_in[i];
    a.out = (float*)d_out; a.ws = (unsigned char*)d_ws;
#if MK_N_LAUNCHES == 1
    a.ph_lo = 0; a.ph_hi = NPHASE;
    void* args[] = {&a};
    hipError_t e = hipLaunchCooperativeKernel((const void*)fwd_kernel, dim3(grid), dim3(NTHR), args, LDS_BYTES, stream);
    if (e != hipSuccess) fprintf(stderr, "kernel_launch: cooperative launch failed: %s (grid %d)\n", hipGetErrorString(e), grid);
#else
    for (int p = 0; p < NPHASE; ++p) { a.ph_lo = p; a.ph_hi = p + 1; hipLaunchKernelGGL(fwd_kernel, dim3(grid), dim3(NTHR), LDS_BYTES, stream, a); }
#endif
}
```

```cpp
#include <hip/hip_runtime.h>
#include <hip/hip_cooperative_groups.h>
#include <cstdio>
#include <cstdint>
namespace cg = cooperative_groups;
namespace pg8 {
#define PG8_LAS __attribute__((address_space(3)))
typedef unsigned short bf16_t;
typedef short bf16x8 __attribute__((ext_vector_type(8)));
typedef float f32x4 __attribute__((ext_vector_type(4)));
typedef unsigned u32x4 __attribute__((ext_vector_type(4)));
constexpr int BM = 256, BK = 64, HALF = 128, HTB = HALF * BK * 2  , STAGE_BYTES = 8 * HTB, NXCD = 8, WGM = 8;

__host__ __device__ __forceinline__ int lds_byte(int r, int c) { const int st = (r >> 4) * 2 + (c >> 5), rr = r & 15, cc = c & 31, ob = rr * 64 + cc * 2; return st * 1024 + (ob ^ (((ob >> 9) & 1) << 5)); }
__host__ __device__ __forceinline__ void stage_rc(int b, int& R, int& C) { const int st = b / 1024, sb = b % 1024, swz = sb ^ (((sb >> 9) & 1) << 5); R = (st >> 1) * 16 + swz / 64; C = (st & 1) * 32 + (swz % 64) / 2; }
__host__ __device__ __forceinline__ int perm32(int rho) { const int n = rho >> 4, i = rho & 15; return 8 * (i >> 2) + 4 * n + (i & 3); }

struct Unit { int pm, pn, ks; };
struct Gemm { const bf16_t* A; const bf16_t* Bt; int M, N, K; int ld = 0; };

struct StaticOrder {
    int nM, nN, nwg, G, c;
    __host__ __device__ void init(int M, int N, int G_, int c_) { nM = M / BM; nN = N / BM; nwg = nM * nN; G = G_; c = c_; }
    __host__ __device__ bool next(int i, Unit& u) const {
        const long L = (long)i * G + c; if (L >= nwg) return false;
        int wgid = (int)L; { const int q = nwg / NXCD, r = nwg % NXCD, xcd = wgid % NXCD, off = wgid / NXCD; wgid = (xcd < r ? xcd * (q + 1) : r * (q + 1) + (xcd - r) * q) + off; }
        const int nig = WGM * nN, gid = wgid / nig, fm = gid * WGM, gsz = (nM - fm) < WGM ? (nM - fm) : WGM;
        u.pm = fm + ((wgid % nig) % gsz); u.pn = (wgid % nig) / gsz; u.ks = 0; return true;
    }
    __device__ __forceinline__ void a_ready(const Unit&) const {}
    __device__ __forceinline__ void done(const Unit&) const {}
};
__device__ __forceinline__ unsigned cvt_pk_bf16(float lo, float hi) { unsigned r; asm volatile("v_cvt_pk_bf16_f32 %0, %1, %2" : "=v"(r) : "v"(lo), "v"(hi)); return r; }
template <class Epi, class Sched, bool ALIGN_EPI = false, bool SP2 = false>
__device__ __forceinline__ void gemm_phase(PG8_LAS unsigned char* lds, const Gemm g, const Sched& S, const Epi& E) {
    const int tid = threadIdx.x, wid = __builtin_amdgcn_readfirstlane(tid >> 6), lane = tid & 63, wr = wid >> 2, wc = wid & 3, fr = lane & 15, fq = lane >> 4;
    const int K = g.K, nt = K / BK, LD = g.ld ? g.ld : g.K;
    unsigned voffA[2], voffB[2];
#pragma unroll
    for (int i = 0; i < 2; ++i) { int R, C; stage_rc(tid * 16 + i * 8192, R, C); const int Rb = Epi::PERM ? ((R & ~31) + perm32(R & 31)) : R;
        voffA[i] = (unsigned)(R * LD + C) * 2u; voffB[i] = (unsigned)(Rb * LD + C) * 2u; }
    const size_t kstep = (size_t)(BK * 2);
    const size_t hstep = (size_t)HALF * LD * 2;
    const size_t tstep = 2 * hstep;
    const unsigned ldsw = (unsigned)wid * 1024u;
    const int aoff = lds_byte(wr * 64 + fr, fq * 8), boff = lds_byte(wc * 32 + fr, fq * 8);
#define PG8_SA(b, h) (((b) * 2 + (h)) * HTB)
#define PG8_SB(b, h) ((4 + (b) * 2 + (h)) * HTB)
#define PG8_STAGE(bufoff, gbase, voff) do { _Pragma("unroll") for (int _i = 0; _i < 2; ++_i) \
        __builtin_amdgcn_global_load_lds((const unsigned*)((const char*)(gbase) + (voff)[_i]), (PG8_LAS unsigned*)(lds + (bufoff) + ldsw + _i * 8192), 16, 0, 0); } while (0)
#define PG8_LDA(dst, b, h) do { _Pragma("unroll") for (int m = 0; m < 4; ++m) _Pragma("unroll") for (int k = 0; k < 2; ++k) dst[m][k] = *(const PG8_LAS bf16x8*)(lds + PG8_SA(b, h) + aoff + m * 2048 + k * 1024); } while (0)
#define PG8_LDB(dst, b, h) do { _Pragma("unroll") for (int n = 0; n < 2; ++n) _Pragma("unroll") for (int k = 0; k < 2; ++k) dst[n][k] = *(const PG8_LAS bf16x8*)(lds + PG8_SB(b, h) + boff + n * 2048 + k * 1024); } while (0)
#define PG8_MMA(ai, bj, At, Bt) do { __builtin_amdgcn_s_setprio(1); _Pragma("unroll") for (int m = 0; m < 4; ++m) _Pragma("unroll") for (int n = 0; n < 2; ++n) _Pragma("unroll") for (int k = 0; k < 2; ++k) \
        acc[ai][bj][m][n] = __builtin_amdgcn_mfma_f32_16x16x32_bf16(Bt[n][k], At[m][k], acc[ai][bj][m][n], 0, 0, 0); __builtin_amdgcn_s_setprio(0); } while (0)
#define PG8_WAIT_V(n) asm volatile("s_waitcnt vmcnt(" #n ")" ::: "memory")
#define PG8_WAIT_L(n) asm volatile("s_waitcnt lgkmcnt(" #n ")" ::: "memory")
#define PG8_BAR __builtin_amdgcn_s_barrier()
#define PG8_SCHED __builtin_amdgcn_sched_barrier(0)
    Unit cur, nxt; int ui = 0;
    if (!S.next(0, cur)) return;
    f32x4 acc[2][2][4][2];
#pragma unroll
    for (int a = 0; a < 2; ++a)
#pragma unroll
        for (int b = 0; b < 2; ++b)
#pragma unroll
            for (int m = 0; m < 4; ++m)
#pragma unroll
                for (int n = 0; n < 2; ++n) acc[a][b][m][n] = (f32x4){0.f, 0.f, 0.f, 0.f};
    bf16x8 At[4][2], B0[2][2], B1[2][2];
    const char* cA = (const char*)g.A + (size_t)cur.pm * tstep + (size_t)cur.ks * K * 2; const char* cB = (const char*)g.Bt + (size_t)cur.pn * tstep + (size_t)cur.ks * K * 2;
    S.a_ready(cur);
    if constexpr (SP2) {
        PG8_STAGE(PG8_SB(0, 0), cB, voffB); PG8_STAGE(PG8_SB(0, 1), cB + hstep, voffB); PG8_STAGE(PG8_SA(0, 0), cA, voffA); PG8_STAGE(PG8_SA(0, 1), cA + hstep, voffA);
        if (wr == 1) PG8_BAR;
        PG8_WAIT_V(2); PG8_BAR;
        PG8_STAGE(PG8_SB(1, 0), cB + kstep, voffB); PG8_STAGE(PG8_SA(1, 0), cA + kstep, voffA); PG8_STAGE(PG8_SB(1, 1), cB + hstep + kstep, voffB);
        PG8_WAIT_V(6); PG8_BAR;
    } else {
        PG8_STAGE(PG8_SB(0, 0), cB, voffB); PG8_STAGE(PG8_SA(0, 0), cA, voffA); PG8_STAGE(PG8_SB(0, 1), cB + hstep, voffB); PG8_STAGE(PG8_SA(0, 1), cA + hstep, voffA);
        if (wr == 1) PG8_BAR;
        PG8_WAIT_V(4); PG8_BAR;
        PG8_STAGE(PG8_SB(1, 0), cB + kstep, voffB); PG8_STAGE(PG8_SA(1, 0), cA + kstep, voffA); PG8_STAGE(PG8_SB(1, 1), cB + hstep + kstep, voffB);
        PG8_WAIT_V(6); PG8_BAR;
    }
    for (;;) {
        const bool has_next = S.next(ui + 1, nxt);
        const char* nA = has_next ? (const char*)g.A + (size_t)nxt.pm * tstep + (size_t)nxt.ks * K * 2 : cA; const char* nB = has_next ? (const char*)g.Bt + (size_t)nxt.pn * tstep + (size_t)nxt.ks * K * 2 : cB;
        for (int t = 0; t < nt; t += 2) {
            const bool last = (t == nt - 2);
            const char* a1 = cA + (size_t)(t + 1) * kstep;
            const char* a2 = last ? nA : cA + (size_t)(t + 2) * kstep; const char* b2 = last ? nB : cB + (size_t)(t + 2) * kstep;
            const char* a3 = a2 + kstep; const char* b3 = b2 + kstep;
            if (last && has_next) S.a_ready(nxt);
            if constexpr (SP2) {
            PG8_LDB(B0, 0, 0); PG8_LDB(B1, 0, 1); PG8_SCHED; PG8_LDA(At, 0, 0); PG8_STAGE(PG8_SA(1, 1), a1 + hstep, voffA);
            PG8_WAIT_V(8); PG8_WAIT_L(0); PG8_BAR; PG8_MMA(0, 0, At, B0); PG8_MMA(0, 1, At, B1); PG8_BAR; PG8_SCHED;
            PG8_LDA(At, 0, 1); PG8_STAGE(PG8_SB(0, 0), b2, voffB); PG8_STAGE(PG8_SB(0, 1), b2 + hstep, voffB); PG8_STAGE(PG8_SA(0, 0), a2, voffA);
            PG8_WAIT_V(8); PG8_WAIT_L(0); PG8_BAR; PG8_MMA(1, 0, At, B0); PG8_MMA(1, 1, At, B1); PG8_BAR; PG8_SCHED;
            PG8_LDB(B0, 1, 0); PG8_LDB(B1, 1, 1); PG8_SCHED; PG8_LDA(At, 1, 0); PG8_STAGE(PG8_SA(0, 1), a2 + hstep, voffA);
            PG8_WAIT_V(8); PG8_WAIT_L(0); PG8_BAR; PG8_MMA(0, 0, At, B0); PG8_MMA(0, 1, At, B1); PG8_BAR; PG8_SCHED;
            PG8_LDA(At, 1, 1); PG8_STAGE(PG8_SB(1, 0), b3, voffB); PG8_STAGE(PG8_SB(1, 1), b3 + hstep, voffB); PG8_STAGE(PG8_SA(1, 0), a3, voffA);
            PG8_WAIT_V(8); PG8_WAIT_L(0); PG8_BAR; PG8_MMA(1, 0, At, B0); PG8_MMA(1, 1, At, B1); PG8_BAR; PG8_SCHED;
            } else {
            PG8_LDB(B0, 0, 0); PG8_SCHED; PG8_LDA(At, 0, 0); PG8_STAGE(PG8_SA(1, 1), a1 + hstep, voffA);
            PG8_WAIT_L(8); PG8_BAR; PG8_WAIT_L(0); PG8_MMA(0, 0, At, B0); PG8_BAR; PG8_SCHED;
            PG8_LDB(B1, 0, 1); PG8_STAGE(PG8_SB(0, 0), b2, voffB);
            PG8_BAR; PG8_WAIT_L(0); PG8_MMA(0, 1, At, B1); PG8_BAR;
            PG8_LDA(At, 0, 1); PG8_STAGE(PG8_SA(0, 0), a2, voffA);
            PG8_BAR; PG8_WAIT_L(0); PG8_MMA(1, 0, At, B0); PG8_BAR; PG8_SCHED;
            PG8_STAGE(PG8_SB(0, 1), b2 + hstep, voffB);
            PG8_WAIT_V(6); PG8_BAR; PG8_MMA(1, 1, At, B1); PG8_BAR;
            PG8_LDB(B0, 1, 0); PG8_SCHED; PG8_LDA(At, 1, 0); PG8_STAGE(PG8_SA(0, 1), a2 + hstep, voffA);
            PG8_WAIT_L(8); PG8_BAR; PG8_WAIT_L(0); PG8_MMA(0, 0, At, B0); PG8_BAR; PG8_SCHED;
            PG8_LDB(B1, 1, 1); PG8_STAGE(PG8_SB(1, 0), b3, voffB);
            PG8_BAR; PG8_WAIT_L(0); PG8_MMA(0, 1, At, B1); PG8_BAR;
            PG8_LDA(At, 1, 1); PG8_STAGE(PG8_SA(1, 0), a3, voffA);
            PG8_BAR; PG8_WAIT_L(0); PG8_MMA(1, 0, At, B0); PG8_BAR; PG8_SCHED;
            PG8_STAGE(PG8_SB(1, 1), b3 + hstep, voffB);
            PG8_WAIT_V(6); PG8_BAR; PG8_MMA(1, 1, At, B1); PG8_BAR;
            }
        }
        if constexpr (ALIGN_EPI) { if (wr == 0) PG8_BAR; }
        if constexpr (!Epi::AFTER_DRAIN) { E(acc, cur, wr, wc, fr, fq); S.done(cur); }
        if (!has_next) break;
#pragma unroll
        for (int a = 0; a < 2; ++a)
#pragma unroll
            for (int b = 0; b < 2; ++b)
#pragma unroll
                for (int m = 0; m < 4; ++m)
#pragma unroll
                    for (int n = 0; n < 2; ++n) acc[a][b][m][n] = (f32x4){0.f, 0.f, 0.f, 0.f};
        cur = nxt; cA = nA; cB = nB; ++ui;
        if constexpr (ALIGN_EPI) { if (wr == 1) PG8_BAR; }
    }
    PG8_WAIT_V(0);
    if constexpr (!ALIGN_EPI) { if (wr == 0) PG8_BAR; }
    PG8_BAR;
    if constexpr (Epi::AFTER_DRAIN) { E.fused(acc, cur, wr, wc, fr, fq, lds, wid, lane); S.done(cur); }
#undef PG8_SA
#undef PG8_SB
#undef PG8_STAGE
#undef PG8_LDA
#undef PG8_LDB
#undef PG8_MMA
#undef PG8_WAIT_V
#undef PG8_WAIT_L
#undef PG8_BAR
#undef PG8_SCHED
}
}


#define LAS __attribute__((address_space(3)))
typedef unsigned short bf16;
typedef float f32x4 __attribute__((ext_vector_type(4)));
typedef float f32x2 __attribute__((ext_vector_type(2)));
typedef short bf16x8 __attribute__((ext_vector_type(8)));
typedef unsigned u32x4 __attribute__((ext_vector_type(4)));
typedef unsigned u32x2 __attribute__((ext_vector_type(2)));

constexpr int NWAVES = 8, NTHR = 512;
constexpr int DM = 2048, NB = 4, SEQ = 4096, CTXL = 256, FFH = 5632;
constexpr int MLAT = NB * SEQ, MCTX = NB * CTXL, MTOT = MLAT + MCTX;
constexpr int EVEN_IN = 6160, ODD_IN = 7712;
constexpr int LDP0 = 6144, LDP1 = 7680;
constexpr int NMODC = 6 * DM;
constexpr float EPS = 1e-6f;

constexpr size_t MiB = 1u << 20;
constexpr size_t WS_MOD = 0, WS_WIN = 1 * MiB, WS_WOUT = 32 * MiB, WS_W13 = 40 * MiB, WS_W2 = 84 * MiB, WS_A = 106 * MiB, WS_P = 174 * MiB,
                 WS_G = 429 * MiB, WS_Y = 432 * MiB, WS_VT = 500 * MiB, WS_DIRB = 551 * MiB, WS_XC = 619 * MiB, WS_PART = 627 * MiB, WS_XB = 659 * MiB, WS_END = 723 * MiB;
constexpr size_t WS_BAR = 768 * 1024, BAR_BYTES = 16384;
constexpr size_t DIRSZ = (size_t)MTOT * 1024;
constexpr int LDS_BYTES = 163840;

typedef __bf16 bf16x2_t __attribute__((ext_vector_type(2)));
__device__ __forceinline__ unsigned pk2(float lo, float hi) { const f32x2 v = {lo, hi}; const bf16x2_t b = __builtin_convertvector(v, bf16x2_t); return __builtin_bit_cast(unsigned, b); }
__device__ __forceinline__ unsigned f2bf(float f) { return pk2(f, f) & 0xffffu; }
__device__ __forceinline__ float bflo(unsigned u) { return __builtin_bit_cast(float, u << 16); }
__device__ __forceinline__ float bfhi(unsigned u) { return __builtin_bit_cast(float, u & 0xffff0000u); }
__device__ __forceinline__ float fexp(float x) { return __expf(x); }
__device__ __forceinline__ float sigmoidf_(float x) { return __builtin_amdgcn_rcpf(1.f + __expf(-x)); }
__device__ __forceinline__ float siluf_(float x) { return x * __builtin_amdgcn_rcpf(1.f + __expf(-x)); }
__device__ __forceinline__ float softplusf_(float x) { return fmaxf(x, 0.f) + __logf(1.f + __expf(-fabsf(x))); }
__device__ __forceinline__ float logsigmoidf_(float x) { return fminf(x, 0.f) - __logf(1.f + __expf(-fabsf(x))); }
__device__ __forceinline__ float wave_sum(float v) {
#pragma unroll
    for (int o = 1; o < 64; o <<= 1) v += __shfl_xor(v, o);
    return v;
}
__device__ __forceinline__ float sum8(float v) {
    v += __builtin_bit_cast(float, __builtin_amdgcn_update_dpp(0, __builtin_bit_cast(int, v), 0xB1, 0xF, 0xF, true));
    v += __builtin_bit_cast(float, __builtin_amdgcn_update_dpp(0, __builtin_bit_cast(int, v), 0x4E, 0xF, 0xF, true));
    v += __builtin_bit_cast(float, __builtin_amdgcn_update_dpp(0, __builtin_bit_cast(int, v), 0x141, 0xF, 0xF, true));
    return v;
}
template <int CTRL, int RM> __device__ __forceinline__ float dppmov(float oldv, float v) {
    return __builtin_bit_cast(float, __builtin_amdgcn_update_dpp(__builtin_bit_cast(int, oldv), __builtin_bit_cast(int, v), CTRL, RM, 0xF, false)); }
__device__ __forceinline__ float wave_scan_add(float x) {
    x += dppmov<0x111, 0xF>(0.f, x); x += dppmov<0x112, 0xF>(0.f, x); x += dppmov<0x114, 0xF>(0.f, x); x += dppmov<0x118, 0xF>(0.f, x);
    x += dppmov<0x142, 0xA>(0.f, x); x += dppmov<0x143, 0xC>(0.f, x); return x; }
__device__ __forceinline__ float wave_scan_max(float x) {
    const float NEG = -3.0e38f;
    x = fmaxf(x, dppmov<0x111, 0xF>(NEG, x)); x = fmaxf(x, dppmov<0x112, 0xF>(NEG, x)); x = fmaxf(x, dppmov<0x114, 0xF>(NEG, x)); x = fmaxf(x, dppmov<0x118, 0xF>(NEG, x));
    x = fmaxf(x, dppmov<0x142, 0xA>(NEG, x)); x = fmaxf(x, dppmov<0x143, 0xC>(NEG, x)); return x; }
__device__ __forceinline__ float lane63(float x) { return __builtin_bit_cast(float, __builtin_amdgcn_readlane(__builtin_bit_cast(int, x), 63)); }
#define LDS_WAIT() asm volatile("s_waitcnt lgkmcnt(0)" ::: "memory")

struct EpiProj {
    static constexpr bool PERM = true, AFTER_DRAIN = false;
    bf16* O; int ldc; int ntile_main; float* G; int ng;
    __device__ __forceinline__ void operator()(const f32x4 (&acc)[2][2][4][2], const pg8::Unit& u, int wr, int wc, int fr, int fq) const {
        const int row0 = u.pm * 256 + wr * 64 + fr;
        if (u.pn < ntile_main) {
            const int col0 = u.pn * 256 + wc * 32 + 8 * fq;
#pragma unroll
            for (int ai = 0; ai < 2; ++ai)
#pragma unroll
                for (int m = 0; m < 4; ++m) { bf16* rowp = O + (size_t)(row0 + ai * 128 + m * 16) * ldc + col0;
#pragma unroll
                    for (int bj = 0; bj < 2; ++bj) { const f32x4 v0 = acc[ai][bj][m][0], v1 = acc[ai][bj][m][1];
                        u32x4 w; w.x = pg8::cvt_pk_bf16(v0[0], v0[1]); w.y = pg8::cvt_pk_bf16(v0[2], v0[3]); w.z = pg8::cvt_pk_bf16(v1[0], v1[1]); w.w = pg8::cvt_pk_bf16(v1[2], v1[3]);
                        *(u32x4*)(rowp + bj * 128) = w; } }
        } else if (wc == 0) {
#pragma unroll
            for (int ai = 0; ai < 2; ++ai)
#pragma unroll
                for (int m = 0; m < 4; ++m) { float* rowp = G + (size_t)(row0 + ai * 128 + m * 16) * 32;
#pragma unroll
                    for (int n = 0; n < 2; ++n) { const int c = 8 * fq + 4 * n; if (c < ng) *(f32x4*)(rowp + c) = acc[ai][0][m][n]; } }
        }
    }
};
constexpr int NTG = MTOT / 4;
struct EpiBf {
    static constexpr bool PERM = true, AFTER_DRAIN = false;
    bf16* O; int ldc;
    __device__ __forceinline__ void operator()(const f32x4 (&acc)[2][2][4][2], const pg8::Unit& u, int wr, int wc, int fr, int fq) const {
        const int row0 = u.pm * 256 + wr * 64 + fr, col0 = u.pn * 256 + wc * 32 + 8 * fq;
#pragma unroll
        for (int ai = 0; ai < 2; ++ai)
#pragma unroll
            for (int m = 0; m < 4; ++m) { const int row = row0 + ai * 128 + m * 16, hh = row >> 7, d = row & 127;
#pragma unroll
                for (int bj = 0; bj < 2; ++bj) { const f32x4 v0 = acc[ai][bj][m][0], v1 = acc[ai][bj][m][1];
                    const int tg = (col0 + bj * 128) >> 2;
                    u32x2 w0, w1; w0.x = pg8::cvt_pk_bf16(v0[0], v0[1]); w0.y = pg8::cvt_pk_bf16(v0[2], v0[3]); w1.x = pg8::cvt_pk_bf16(v1[0], v1[1]); w1.y = pg8::cvt_pk_bf16(v1[2], v1[3]);
                    *(u32x2*)(O + (((size_t)hh * NTG + tg) * 128 + d) * 4) = w0; *(u32x2*)(O + (((size_t)hh * NTG + tg + 1) * 128 + d) * 4) = w1; } }
    }
};
struct EpiSwiglu {
    static constexpr bool PERM = true, AFTER_DRAIN = false;
    bf16* H; int ldc;
    __device__ __forceinline__ void operator()(const f32x4 (&acc)[2][2][4][2], const pg8::Unit& u, int wr, int wc, int fr, int fq) const {
        const int row0 = u.pm * 256 + wr * 64 + fr, col0 = u.pn * 128 + wc * 32 + 8 * fq;
#pragma unroll
        for (int ai = 0; ai < 2; ++ai)
#pragma unroll
            for (int m = 0; m < 4; ++m) {
                float h[8];
#pragma unroll
                for (int n = 0; n < 2; ++n)
#pragma unroll
                    for (int j = 0; j < 4; ++j) { const float a = acc[ai][0][m][n][j], b = acc[ai][1][m][n][j]; h[n * 4 + j] = a * __builtin_amdgcn_rcpf(1.f + __expf(-a)) * b; }
                u32x4 w; w.x = pg8::cvt_pk_bf16(h[0], h[1]); w.y = pg8::cvt_pk_bf16(h[2], h[3]); w.z = pg8::cvt_pk_bf16(h[4], h[5]); w.w = pg8::cvt_pk_bf16(h[6], h[7]);
                *(u32x4*)(H + (size_t)(row0 + ai * 128 + m * 16) * ldc + col0) = w; }
    }
};
template <bool SBF, bool DBF> struct EpiRes {
    static constexpr bool PERM = true, AFTER_DRAIN = false;
    const void* src; void* dst; const float* gate;
    __device__ __forceinline__ void operator()(const f32x4 (&acc)[2][2][4][2], const pg8::Unit& u, int wr, int wc, int fr, int fq) const {
        const int row0 = u.pm * 256 + wr * 64 + fr, col0 = u.pn * 256 + wc * 32 + 8 * fq;
        const float* g = gate + (size_t)(u.pm >> 4) * NMODC + col0;
        f32x4 gv[2][2];
#pragma unroll
        for (int bj = 0; bj < 2; ++bj)
#pragma unroll
            for (int n = 0; n < 2; ++n) gv[bj][n] = *(const f32x4*)(g + bj * 128 + n * 4);
#pragma unroll
        for (int ai = 0; ai < 2; ++ai)
#pragma unroll
            for (int m = 0; m < 4; ++m) { const size_t off = (size_t)(row0 + ai * 128 + m * 16) * DM + col0;
#pragma unroll
                for (int bj = 0; bj < 2; ++bj) { f32x4 s0, s1;
                    if (SBF) { const u32x4 uu = *(const u32x4*)((const bf16*)src + off + bj * 128); s0 = (f32x4){bflo(uu.x), bfhi(uu.x), bflo(uu.y), bfhi(uu.y)}; s1 = (f32x4){bflo(uu.z), bfhi(uu.z), bflo(uu.w), bfhi(uu.w)}; }
                    else { s0 = *(const f32x4*)((const float*)src + off + bj * 128); s1 = *(const f32x4*)((const float*)src + off + bj * 128 + 4); }
                    const f32x4 r0 = s0 + gv[bj][0] * acc[ai][bj][m][0], r1 = s1 + gv[bj][1] * acc[ai][bj][m][1];
                    if (DBF) { u32x4 w; w.x = pk2(r0[0], r0[1]); w.y = pk2(r0[2], r0[3]); w.z = pk2(r1[0], r1[1]); w.w = pk2(r1[2], r1[3]); *(u32x4*)((bf16*)dst + off + bj * 128) = w; }
                    else { *(f32x4*)((float*)dst + off + bj * 128) = r0; *(f32x4*)((float*)dst + off + bj * 128 + 4) = r1; } } }
    }
};

template <int MODE>
__device__ __forceinline__ void transpose_item(const float* W, int K, int N, bf16* WT, LAS float* scr, int item, int lane) {
    const int nblk = (N + 31) / 32, kb = item / nblk, nb = item % nblk, k0 = 64 * kb, n0 = 32 * nb;
    const int n4 = (lane & 7) * 4; const bool okc = (n0 + n4) < N;
    f32x4 vld[8];
#pragma unroll
    for (int i = 0; i < 8; ++i) { const int kk = (lane >> 3) + 8 * i; vld[i] = okc ? *(const f32x4*)(W + (size_t)(k0 + kk) * N + n0 + n4) : (f32x4){0.f, 0.f, 0.f, 0.f}; }
#pragma unroll
    for (int i = 0; i < 8; ++i) { const int kk = (lane >> 3) + 8 * i;
#pragma unroll
        for (int e = 0; e < 4; ++e) scr[kk * 33 + n4 + e] = vld[i][e]; }
    LDS_WAIT(); asm volatile("" ::: "memory");
    const int c = lane & 7;
#pragma unroll
    for (int j = 0; j < 4; ++j) { const int n = (lane >> 3) + 8 * j; const LAS float* s = scr + (8 * c) * 33 + n;
        u32x4 o; o.x = pk2(s[0 * 33], s[1 * 33]); o.y = pk2(s[2 * 33], s[3 * 33]); o.z = pk2(s[4 * 33], s[5 * 33]); o.w = pk2(s[6 * 33], s[7 * 33]);
        const int nn = n0 + n; const int row = MODE == 0 ? nn : ((nn >> 7) * 256 + (nn & 127) + (MODE == 2 ? 128 : 0));
        *(u32x4*)(WT + (size_t)row * K + k0 + 8 * c) = o; }
    LDS_WAIT(); asm volatile("" ::: "memory");
}
__device__ __forceinline__ void convert_weights(LAS unsigned char* lds, unsigned char* ws, const float* w_in, int n_in, const float* w_out, const float* w1, const float* w3, const float* w2, int which, int wg, int nwg) {
    const int lane = threadIdx.x & 63, wave = threadIdx.x >> 6;
    LAS float* scr = (LAS float*)(lds + wave * 16384);
    const int gw = wg * NWAVES + wave, NGW = nwg * NWAVES;
    const int I_IN = (DM / 64) * ((n_in + 31) / 32), I_O = (DM / 64) * (DM / 32), I_1 = (DM / 64) * (FFH / 32), I_2 = (FFH / 64) * (DM / 32);
    const int n0 = (which & 1) ? I_IN : 0, n1 = (which & 2) ? I_O : 0, n2 = (which & 4) ? I_1 : 0, n3 = (which & 8) ? I_1 : 0, n4 = (which & 16) ? I_2 : 0;
    for (int it = gw; it < n0 + n1 + n2 + n3 + n4; it += NGW) {
        int r = it;
        if (r < n0) { transpose_item<0>(w_in, DM, n_in, (bf16*)(ws + WS_WIN), scr, r, lane); continue; } r -= n0;
        if (r < n1) { transpose_item<0>(w_out, DM, DM, (bf16*)(ws + WS_WOUT), scr, r, lane); continue; } r -= n1;
        if (r < n2) { transpose_item<1>(w1, DM, FFH, (bf16*)(ws + WS_W13), scr, r, lane); continue; } r -= n2;
        if (r < n3) { transpose_item<2>(w3, DM, FFH, (bf16*)(ws + WS_W13), scr, r, lane); continue; } r -= n3;
        transpose_item<0>(w2, FFH, DM, (bf16*)(ws + WS_W2), scr, r, lane);
    }
}
__device__ __forceinline__ void mod_gemv(LAS unsigned char* lds, const float* c, const float* c_ctx, const float* mw0, const float* mb0, const float* mw1, const float* mb1, float* MOD) {
    LAS float* scv = (LAS float*)lds;
    LAS float* red = (LAS float*)(lds + 40960);
    const int tid = threadIdx.x;
    __syncthreads();
    for (int idx = tid; idx < 5 * DM; idx += NTHR) { const int i = idx >> 11, k = idx & 2047; const float cv = (i < 4) ? c[i * DM + k] : c_ctx[k]; scv[idx] = siluf_(cv); }
    __syncthreads();
    const int rg = tid >> 3, cl = tid & 7;
    for (int it = blockIdx.x; it < 768; it += gridDim.x) {
        const int layer = it / 384, c0 = (it % 384) * 32;
        const float* W = layer ? mw1 : mw0; const float* bias = layer ? mb1 : mb0;
        f32x4 acc[5];
#pragma unroll
        for (int i = 0; i < 5; ++i) acc[i] = (f32x4){0.f, 0.f, 0.f, 0.f};
#pragma unroll 8
        for (int s = 0; s < 32; ++s) { const int k = s * 64 + rg; const f32x4 w = *(const f32x4*)(W + (size_t)k * NMODC + c0 + cl * 4);
#pragma unroll
            for (int i = 0; i < 5; ++i) acc[i] += scv[i * DM + k] * w; }
#pragma unroll
        for (int i = 0; i < 5; ++i) *(LAS f32x4*)(red + (rg * 5 + i) * 32 + cl * 4) = acc[i];
        __syncthreads();
        if (tid < 160) { const int i = tid >> 5, col = tid & 31; float s = 0.f;
            for (int r = 0; r < 64; ++r) s += red[(r * 5 + i) * 32 + col];
            MOD[(size_t)(layer * 5 + i) * NMODC + c0 + col] = s + bias[c0 + col]; }
        __syncthreads();
    }
}

template <bool LATBF>
__device__ __forceinline__ void phase_modulate(const void* xl, const float* xc, const float* mod, int shc, int scc, bf16* A, int nrows,
                                               const float* part = nullptr, const float* csrc = nullptr, const float* cgate = nullptr, float* xc_out = nullptr) {
    const int lane = threadIdx.x & 63, wave = threadIdx.x >> 6;
    const int gw = blockIdx.x * NWAVES + wave, NGW = gridDim.x * NWAVES;
    constexpr int NR = LATBF ? 4 : 2;
    for (int row0 = gw; row0 < nrows; row0 += NR * NGW) {
        f32x4 v[NR][8];
#pragma unroll
        for (int k = 0; k < NR; ++k) { const int row = row0 + k * NGW;
            if (row < nrows) {
                if (row >= MLAT) {
                    const size_t ro = (size_t)(row - MLAT) * DM;
                    if (part != nullptr) {
#pragma unroll
                        for (int q = 0; q < 8; ++q) { const int c4 = 2 * lane + 128 * (q >> 1) + (q & 1);
                            const f32x4 p = (((const f32x4*)(part + ro))[c4] + ((const f32x4*)(part + (size_t)MCTX * DM + ro))[c4]) + (((const f32x4*)(part + (size_t)2 * MCTX * DM + ro))[c4] + ((const f32x4*)(part + (size_t)3 * MCTX * DM + ro))[c4]);
                            v[k][q] = ((const f32x4*)(csrc + ro))[c4] + ((const f32x4*)cgate)[c4] * p; ((f32x4*)(xc_out + ro))[c4] = v[k][q]; }
                    } else {
#pragma unroll
                        for (int q = 0; q < 8; ++q) v[k][q] = ((const f32x4*)(xc + ro))[2 * lane + 128 * (q >> 1) + (q & 1)];
                    }
                } else if (LATBF) {
#pragma unroll
                    for (int j = 0; j < 4; ++j) { const u32x4 uu = ((const u32x4*)((const bf16*)xl + (size_t)row * DM))[lane + 64 * j];
                        v[k][2 * j] = (f32x4){bflo(uu.x), bfhi(uu.x), bflo(uu.y), bfhi(uu.y)}; v[k][2 * j + 1] = (f32x4){bflo(uu.z), bfhi(uu.z), bflo(uu.w), bfhi(uu.w)}; }
                } else {
#pragma unroll
                    for (int q = 0; q < 8; ++q) v[k][q] = ((const f32x4*)((const float*)xl + (size_t)row * DM))[2 * lane + 128 * (q >> 1) + (q & 1)];
                }
            } }
#pragma unroll
        for (int k = 0; k < NR; ++k) { const int row = row0 + k * NGW;
            if (row < nrows) {
                const int bi = row < MLAT ? (row >> 12) : 4;
                const f32x4* sh = (const f32x4*)(mod + (size_t)bi * NMODC + shc * DM); const f32x4* sc = (const f32x4*)(mod + (size_t)bi * NMODC + scc * DM);
                float ss = 0.f;
#pragma unroll
                for (int q = 0; q < 8; ++q) ss += (v[k][q].x * v[k][q].x + v[k][q].y * v[k][q].y) + (v[k][q].z * v[k][q].z + v[k][q].w * v[k][q].w);
                const float r = __builtin_amdgcn_rsqf(wave_sum(ss) * (1.f / DM) + EPS);
                u32x4* o = (u32x4*)(A + (size_t)row * DM);
#pragma unroll
                for (int j = 0; j < 4; ++j) { const int c4 = 2 * lane + 128 * j;
                    const f32x4 y0 = v[k][2 * j] * r * (sc[c4] + 1.f) + sh[c4], y1 = v[k][2 * j + 1] * r * (sc[c4 + 1] + 1.f) + sh[c4 + 1];
                    u32x4 w; w.x = pk2(y0.x, y0.y); w.y = pk2(y0.z, y0.w); w.z = pk2(y1.x, y1.y); w.w = pk2(y1.z, y1.w); o[lane + 64 * j] = w; }
            } }
    }
}

__device__ __forceinline__ float qmax4(float v) { v = fmaxf(v, __shfl_xor(v, 16)); v = fmaxf(v, __shfl_xor(v, 32)); return v; }
__device__ __forceinline__ float qsum4(float v) { v += __shfl_xor(v, 16); v += __shfl_xor(v, 32); return v; }

__device__ __forceinline__ void na_tile(int wt, const bf16* P, const bf16* Vt, const float* qg, const float* kg, const float* rpb, bf16* Y, int lane) {
    const bool isctx = wt >= 8192;
    int b, h, r = 0, j = 0, qrow0;
    if (!isctx) { j = wt & 3; r = (wt >> 2) & 63; h = (wt >> 8) & 7; b = wt >> 11; qrow0 = b * SEQ + r * 64 + j * 16; }
    else { const int x = wt - 8192; h = (x >> 4) & 7; b = x >> 7; qrow0 = MLAT + b * CTXL + (x & 15) * 16; }
    const int li = lane & 15, quad = lane >> 4;
    const int r0 = min(max(r - 4, 0), 56), kstart = min(max(j * 16 - 8, 0), 32);
    const int qc = j * 16 + li, wst = min(max(qc - 8, 0), 48);
    float kgv[32];
    bf16x8 qf[4];
    {
        float qv[32]; float ss = 0.f;
        const bf16* qp = P + (size_t)(qrow0 + li) * LDP0 + h * 128 + quad * 8;
#pragma unroll
        for (int ds = 0; ds < 4; ++ds) { const u32x4 u = *(const u32x4*)(qp + ds * 32);
#pragma unroll
            for (int e = 0; e < 4; ++e) { qv[ds * 8 + 2 * e] = bflo(u[e]); qv[ds * 8 + 2 * e + 1] = bfhi(u[e]); } }
#pragma unroll
        for (int e = 0; e < 32; ++e) ss += qv[e] * qv[e];
        ss = qsum4(ss);
        const float rn = (__builtin_amdgcn_rsqf(ss * (1.f / 128.f) + EPS)) * 0.08838834764831845f;
#pragma unroll
        for (int ds = 0; ds < 4; ++ds) { const f32x4 g0 = *(const f32x4*)(qg + ds * 32 + quad * 8), g1 = *(const f32x4*)(qg + ds * 32 + quad * 8 + 4);
            const f32x4 k0 = *(const f32x4*)(kg + ds * 32 + quad * 8), k1 = *(const f32x4*)(kg + ds * 32 + quad * 8 + 4);
#pragma unroll
            for (int e = 0; e < 4; ++e) { kgv[ds * 8 + e] = k0[e]; kgv[ds * 8 + 4 + e] = k1[e]; }
            u32x4 w;
            w.x = pk2(qv[ds * 8 + 0] * rn * g0[0], qv[ds * 8 + 1] * rn * g0[1]); w.y = pk2(qv[ds * 8 + 2] * rn * g0[2], qv[ds * 8 + 3] * rn * g0[3]);
            w.z = pk2(qv[ds * 8 + 4] * rn * g1[0], qv[ds * 8 + 5] * rn * g1[1]); w.w = pk2(qv[ds * 8 + 6] * rn * g1[2], qv[ds * 8 + 7] * rn * g1[3]);
            qf[ds] = __builtin_bit_cast(bf16x8, w); }
    }
    float mrun = -1e30f, lrun = 0.f;
    f32x4 O[8];
#pragma unroll
    for (int d = 0; d < 8; ++d) O[d] = (f32x4){0.f, 0.f, 0.f, 0.f};
    const int nloc = isctx ? 0 : 4;
    for (int ch = 0; ch < nloc + 4; ++ch) {
        const bool loc = ch < nloc;
        f32x4 S[4]; int tokb[4];
#pragma unroll
        for (int g4 = 0; g4 < 4; ++g4) {
            int tok0, kr = 0; const int g = g4 & 1;
            if (loc) { kr = r0 + ch * 2 + (g4 >> 1); tok0 = b * SEQ + kr * 64 + kstart + g * 16; }
            else { tok0 = MLAT + b * CTXL + (ch - nloc) * 64 + g4 * 16; }
            tokb[g4] = tok0;
            const bf16* kp = P + (size_t)(tok0 + li) * LDP0 + 1024 + h * 128 + quad * 8;
            float kv[32]; float ss = 0.f;
#pragma unroll
            for (int ds = 0; ds < 4; ++ds) { const u32x4 u = *(const u32x4*)(kp + ds * 32);
#pragma unroll
                for (int e = 0; e < 4; ++e) { kv[ds * 8 + 2 * e] = bflo(u[e]); kv[ds * 8 + 2 * e + 1] = bfhi(u[e]); } }
#pragma unroll
            for (int e = 0; e < 32; ++e) ss += kv[e] * kv[e];
            ss = qsum4(ss);
            const float rn = __builtin_amdgcn_rsqf(ss * (1.f / 128.f) + EPS);
            f32x4 s = (f32x4){0.f, 0.f, 0.f, 0.f};
#pragma unroll
            for (int ds = 0; ds < 4; ++ds) { u32x4 w;
                w.x = pk2(kv[ds * 8 + 0] * rn * kgv[ds * 8 + 0], kv[ds * 8 + 1] * rn * kgv[ds * 8 + 1]); w.y = pk2(kv[ds * 8 + 2] * rn * kgv[ds * 8 + 2], kv[ds * 8 + 3] * rn * kgv[ds * 8 + 3]);
                w.z = pk2(kv[ds * 8 + 4] * rn * kgv[ds * 8 + 4], kv[ds * 8 + 5] * rn * kgv[ds * 8 + 5]); w.w = pk2(kv[ds * 8 + 6] * rn * kgv[ds * 8 + 6], kv[ds * 8 + 7] * rn * kgv[ds * 8 + 7]);
                s = __builtin_amdgcn_mfma_f32_16x16x32_bf16(__builtin_bit_cast(bf16x8, w), qf[ds], s, 0, 0, 0); }
            if (loc) {
                const int drow = kr - r + 7;
#pragma unroll
                for (int e = 0; e < 4; ++e) { const int kc = kstart + g * 16 + quad * 4 + e; const bool ok = (kc >= wst) && (kc < wst + 16);
                    const int dcol = min(max(kc - qc, -15), 15) + 15;
                    const float bias = rpb[(h * 15 + drow) * 31 + dcol];
                    s[e] = ok ? s[e] + bias : -1e30f; }
            }
            S[g4] = s;
        }
        float mx = -1e30f;
#pragma unroll
        for (int g4 = 0; g4 < 4; ++g4)
#pragma unroll
            for (int e = 0; e < 4; ++e) mx = fmaxf(mx, S[g4][e]);
        mx = qmax4(mx);
        const float mnew = fmaxf(mrun, mx), alpha = __expf(mrun - mnew);
        float rs = 0.f;
#pragma unroll
        for (int g4 = 0; g4 < 4; ++g4)
#pragma unroll
            for (int e = 0; e < 4; ++e) { const float p = __expf(S[g4][e] - mnew); S[g4][e] = p; rs += p; }
        rs = qsum4(rs);
        lrun = lrun * alpha + rs; mrun = mnew;
#pragma unroll
        for (int d = 0; d < 8; ++d) O[d] *= alpha;
#pragma unroll
        for (int pr = 0; pr < 2; ++pr) {
            u32x4 w; w.x = pk2(S[2 * pr][0], S[2 * pr][1]); w.y = pk2(S[2 * pr][2], S[2 * pr][3]); w.z = pk2(S[2 * pr + 1][0], S[2 * pr + 1][1]); w.w = pk2(S[2 * pr + 1][2], S[2 * pr + 1][3]);
            const bf16x8 pf = __builtin_bit_cast(bf16x8, w);
            const bf16* v0 = Vt + (size_t)(h * 128 + li) * MTOT + tokb[2 * pr] + quad * 4;
            const bf16* v1 = Vt + (size_t)(h * 128 + li) * MTOT + tokb[2 * pr + 1] + quad * 4;
#pragma unroll
            for (int d = 0; d < 8; ++d) { const u32x2 lo = *(const u32x2*)(v0 + (size_t)d * 16 * MTOT), hi = *(const u32x2*)(v1 + (size_t)d * 16 * MTOT);
                u32x4 vv; vv.x = lo.x; vv.y = lo.y; vv.z = hi.x; vv.w = hi.y;
                O[d] = __builtin_amdgcn_mfma_f32_16x16x32_bf16(__builtin_bit_cast(bf16x8, vv), pf, O[d], 0, 0, 0); }
        }
    }
    const float inv = 1.f / lrun;
    bf16* yp = Y + (size_t)(qrow0 + li) * DM + h * 128 + quad * 4;
#pragma unroll
    for (int d = 0; d < 8; ++d) { u32x2 w; w.x = pk2(O[d][0] * inv, O[d][1] * inv); w.y = pk2(O[d][2] * inv, O[d][3] * inv); *(u32x2*)(yp + d * 16) = w; }
}

__device__ __forceinline__ void na_tile2(int wt, const bf16* P, const bf16* Vt, const float* qg, const float* kg, const float* rpb, bf16* Y, int lane) {
    const bool isctx = wt >= 8192;
    int b, h, r = 0, j = 0, qrow0;
    if (!isctx) { j = wt & 3; r = (wt >> 2) & 63; h = (wt >> 8) & 7; b = wt >> 11; qrow0 = b * SEQ + r * 64 + j * 16; }
    else { const int x = wt - 8192; h = (x >> 4) & 7; b = x >> 7; qrow0 = MLAT + b * CTXL + (x & 15) * 16; }
    const int li = lane & 15, quad = lane >> 4;
    const int r0 = min(max(r - 4, 0), 56), kstart = min(max(j * 16 - 8, 0), 32);
    const int qc = j * 16 + li, wst = min(max(qc - 8, 0), 48);
    bf16x8 qf[4];
    {
        float qv[32]; float ss = 0.f;
        const bf16* qp = P + (size_t)(qrow0 + li) * LDP0 + h * 128 + quad * 8;
#pragma unroll
        for (int ds = 0; ds < 4; ++ds) { const u32x4 u = *(const u32x4*)(qp + ds * 32);
#pragma unroll
            for (int e = 0; e < 4; ++e) { qv[ds * 8 + 2 * e] = bflo(u[e]); qv[ds * 8 + 2 * e + 1] = bfhi(u[e]); } }
#pragma unroll
        for (int e = 0; e < 32; ++e) ss += qv[e] * qv[e];
        ss = qsum4(ss);
        const float rn = (__builtin_amdgcn_rsqf(ss * (1.f / 128.f) + EPS)) * 0.08838834764831845f;
#pragma unroll
        for (int ds = 0; ds < 4; ++ds) { const f32x4 g0 = *(const f32x4*)(qg + ds * 32 + quad * 8) * *(const f32x4*)(kg + ds * 32 + quad * 8), g1 = *(const f32x4*)(qg + ds * 32 + quad * 8 + 4) * *(const f32x4*)(kg + ds * 32 + quad * 8 + 4);
            u32x4 w;
            w.x = pk2(qv[ds * 8 + 0] * rn * g0[0], qv[ds * 8 + 1] * rn * g0[1]); w.y = pk2(qv[ds * 8 + 2] * rn * g0[2], qv[ds * 8 + 3] * rn * g0[3]);
            w.z = pk2(qv[ds * 8 + 4] * rn * g1[0], qv[ds * 8 + 5] * rn * g1[1]); w.w = pk2(qv[ds * 8 + 6] * rn * g1[2], qv[ds * 8 + 7] * rn * g1[3]);
            qf[ds] = __builtin_bit_cast(bf16x8, w); }
    }
    float mrun = -1e30f, lrun = 0.f;
    f32x4 O[8];
#pragma unroll
    for (int d = 0; d < 8; ++d) O[d] = (f32x4){0.f, 0.f, 0.f, 0.f};
    const int nloc8 = isctx ? 0 : 8, nb = nloc8 + 8;
    const bf16* kbase = P + 1024 + h * 128 + quad * 8;
    const bf16* vbase = Vt + (((size_t)h * NTG + quad) * 128 + li) * 4;
    u32x4 KA[8], KB[8]; u32x2 VA[16];
#define NA_TOK0(blk) ((blk) < nloc8 ? (b * SEQ + (r0 + (blk)) * 64 + kstart) : (MLAT + b * CTXL + ((blk) - nloc8) * 32))
#define NA_LOADV(V_, blk) do { const int tok0_ = NA_TOK0(blk); \
        _Pragma("unroll") for (int db = 0; db < 8; ++db) { V_[2 * db] = *(const u32x2*)(vbase + (size_t)(tok0_ >> 2) * 512 + db * 64); V_[2 * db + 1] = *(const u32x2*)(vbase + (size_t)((tok0_ >> 2) + 4) * 512 + db * 64); } } while (0)
#define NA_LOAD(K_, B_, blk) do { const int tok0_ = NA_TOK0(blk); \
        _Pragma("unroll") for (int g = 0; g < 2; ++g) _Pragma("unroll") for (int ds = 0; ds < 4; ++ds) K_[g * 4 + ds] = *(const u32x4*)(kbase + (size_t)(tok0_ + g * 16 + li) * LDP0 + ds * 32); \
        } while (0)
#define NA_COMP(K_, V_, B_, blk) do { f32x4 s_[2]; float B_[8]; \
        if ((blk) < nloc8) { const float* rb_ = rpb + (h * 15 + (r0 + (blk) - r + 7)) * 31; \
            _Pragma("unroll") for (int g = 0; g < 2; ++g) _Pragma("unroll") for (int e = 0; e < 4; ++e) { const int kc_ = kstart + g * 16 + quad * 4 + e; B_[g * 4 + e] = rb_[min(max(kc_ - qc, -15), 15) + 15]; } } \
        _Pragma("unroll") for (int g = 0; g < 2; ++g) { float ss_ = 0.f; \
            _Pragma("unroll") for (int ds = 0; ds < 4; ++ds) _Pragma("unroll") for (int e = 0; e < 4; ++e) { const float lo_ = bflo(K_[g * 4 + ds][e]), hi_ = bfhi(K_[g * 4 + ds][e]); ss_ += lo_ * lo_ + hi_ * hi_; } \
            ss_ = qsum4(ss_); const float rn_ = __builtin_amdgcn_rsqf(ss_ * (1.f / 128.f) + EPS); \
            f32x4 acc_ = (f32x4){0.f, 0.f, 0.f, 0.f}; \
            _Pragma("unroll") for (int ds = 0; ds < 4; ++ds) acc_ = __builtin_amdgcn_mfma_f32_16x16x32_bf16(__builtin_bit_cast(bf16x8, K_[g * 4 + ds]), qf[ds], acc_, 0, 0, 0); \
            _Pragma("unroll") for (int e = 0; e < 4; ++e) acc_[e] *= __shfl(rn_, quad * 4 + e); \
            if ((blk) < nloc8) { _Pragma("unroll") for (int e = 0; e < 4; ++e) { const int kc_ = kstart + g * 16 + quad * 4 + e; acc_[e] = ((kc_ >= wst) && (kc_ < wst + 16)) ? acc_[e] + B_[g * 4 + e] : -1e30f; } } \
            s_[g] = acc_; } \
        float mx_ = fmaxf(fmaxf(fmaxf(s_[0][0], s_[0][1]), fmaxf(s_[0][2], s_[0][3])), fmaxf(fmaxf(s_[1][0], s_[1][1]), fmaxf(s_[1][2], s_[1][3]))); \
        mx_ = qmax4(mx_); const float mnew_ = fmaxf(mrun, mx_), alpha_ = __expf(mrun - mnew_); float rs_ = 0.f; \
        _Pragma("unroll") for (int g = 0; g < 2; ++g) _Pragma("unroll") for (int e = 0; e < 4; ++e) { const float p_ = __expf(s_[g][e] - mnew_); s_[g][e] = p_; rs_ += p_; } \
        rs_ = qsum4(rs_); lrun = lrun * alpha_ + rs_; mrun = mnew_; \
        u32x4 w_; w_.x = pk2(s_[0][0], s_[0][1]); w_.y = pk2(s_[0][2], s_[0][3]); w_.z = pk2(s_[1][0], s_[1][1]); w_.w = pk2(s_[1][2], s_[1][3]); \
        const bf16x8 pf_ = __builtin_bit_cast(bf16x8, w_); \
        _Pragma("unroll") for (int db = 0; db < 8; ++db) { u32x4 vv_; vv_.x = V_[2 * db].x; vv_.y = V_[2 * db].y; vv_.z = V_[2 * db + 1].x; vv_.w = V_[2 * db + 1].y; \
            O[db] = __builtin_amdgcn_mfma_f32_16x16x32_bf16(__builtin_bit_cast(bf16x8, vv_), pf_, O[db] * alpha_, 0, 0, 0); } } while (0)
    NA_LOAD(KA, BA, 0);
    for (int blk = 0; blk < nb; blk += 2) {
        NA_LOADV(VA, blk); NA_LOAD(KB, BB, blk + 1);
        NA_COMP(KA, VA, BA, blk);
        NA_LOADV(VA, blk + 1); if (blk + 2 < nb) NA_LOAD(KA, BA, blk + 2);
        NA_COMP(KB, VA, BB, blk + 1);
    }
#undef NA_TOK0
#undef NA_LOAD
#undef NA_LOADV
#undef NA_COMP
    const float inv = 1.f / lrun;
    bf16* yp = Y + (size_t)(qrow0 + li) * DM + h * 128 + quad * 4;
#pragma unroll
    for (int d = 0; d < 8; ++d) { u32x2 w; w.x = pk2(O[d][0] * inv, O[d][1] * inv); w.y = pk2(O[d][2] * inv, O[d][3] * inv); *(u32x2*)(yp + d * 16) = w; }
}

__device__ __forceinline__ int chain_row(int b, int dir, int ci, int s) {
    if (ci < 4) { int t = ci * 64 + s; if (dir) t = CTXL - 1 - t; return MLAT + b * CTXL + t; }
    int t = (ci - 4) * 64 + s; if (dir) t = SEQ - 1 - t; return b * SEQ + t;
}
__device__ __forceinline__ void st8f(LAS float* p, u32x4 u, float sc) {
    *(LAS f32x4*)p = (f32x4){bflo(u.x) * sc, bfhi(u.x) * sc, bflo(u.y) * sc, bfhi(u.y) * sc};
    *(LAS f32x4*)(p + 4) = (f32x4){bflo(u.z) * sc, bfhi(u.z) * sc, bflo(u.w) * sc, bfhi(u.w) * sc};
}
constexpr int CH_Q = 0, CH_K = 32768, CH_V = 65536, CH_O = 81920, CH_SC = 98304;

__device__ __forceinline__ void mlstm_chain(LAS unsigned char* lds, int c, const bf16* P, const float* G, const float* gate_bias, bf16* Hout) {
    const int vs = c & 3, dir = (c >> 2) & 1, h = (c >> 3) & 3, b = c >> 5;
    LAS float* q_s = (LAS float*)(lds + CH_Q); LAS float* k_s = (LAS float*)(lds + CH_K); LAS float* v_s = (LAS float*)(lds + CH_V);
    LAS float* o_s = (LAS float*)(lds + CH_O); LAS f32x4* sc_s = (LAS f32x4*)(lds + CH_SC);
    const int tid = threadIdx.x, lane = tid & 63, wave = tid >> 6, v = tid >> 3, kq = tid & 7;
    bf16* Hd = Hout + (size_t)dir * DIRSZ;
    const float gb_i = gate_bias[(2 * dir) * 4 + h], gb_f = gate_bias[(2 * dir + 1) * 4 + h];
    float C[16], nn[16];
#pragma unroll
    for (int e = 0; e < 16; ++e) { C[e] = 0.f; nn[e] = 0.f; }
    float mprev = 0.f;
    u32x4 rq[2], rk[2], rv; float gi = 0.f, gf = 0.f;
#define ML_LOAD(ci_) do { \
        _Pragma("unroll") for (int i = 0; i < 2; ++i) { const int idx = tid + NTHR * i, slot = idx >> 4, pc = idx & 15; const bf16* rp = P + (size_t)chain_row(b, dir, (ci_), slot) * LDP0; \
            rq[i] = *(const u32x4*)(rp + 3072 + h * 128 + pc * 8); rk[i] = *(const u32x4*)(rp + 3584 + h * 128 + pc * 8); } \
        { const int slot = tid >> 3, pc = tid & 7; rv = *(const u32x4*)(P + (size_t)chain_row(b, dir, (ci_), slot) * LDP0 + 4096 + h * 256 + vs * 64 + pc * 8); } \
        if (wave == 0) { const float* gp = G + (size_t)chain_row(b, dir, (ci_), lane) * 32; gi = gp[(2 * dir) * 4 + h]; gf = gp[(2 * dir + 1) * 4 + h]; } } while (0)
    ML_LOAD(0);
    for (int ci = 0; ci < 68; ++ci) {
#pragma unroll
        for (int i = 0; i < 2; ++i) { const int idx = tid + NTHR * i, slot = idx >> 4, pc = idx & 15; st8f(q_s + slot * 128 + pc * 8, rq[i], 0.08838834764831845f); st8f(k_s + slot * 128 + pc * 8, rk[i], 1.f); }
        { const int slot = tid >> 3, pc = tid & 7; st8f(v_s + slot * 64 + pc * 8, rv, 1.f); }
        if (wave == 0) {
            const float li_ = gi + gb_i, lf_ = logsigmoidf_(gf + gb_f);
            float F = lf_;
#pragma unroll
            for (int o = 1; o < 64; o <<= 1) { const float t = __shfl_up(F, o); if (lane >= o) F += t; }
            float pm = li_ - F;
#pragma unroll
            for (int o = 1; o < 64; o <<= 1) { const float t = __shfl_up(pm, o); if (lane >= o) pm = fmaxf(pm, t); }
            const float mt = F + fmaxf(mprev, pm);
            float mm1 = __shfl_up(mt, 1); if (lane == 0) mm1 = mprev;
            sc_s[lane] = (f32x4){__expf(lf_ + mm1 - mt), __expf(li_ - mt), __expf(-mt), 0.f};
            mprev = __shfl(mt, 63);
        }
        __syncthreads();
        if (ci + 1 < 68) ML_LOAD(ci + 1);
        for (int t = 0; t < 64; ++t) {
            const f32x4 scv = sc_s[t];
            const float fp = scv.x, ip = scv.y;
            const float iv = ip * v_s[t * 64 + v];
            float pn = 0.f, pd = 0.f;
#pragma unroll
            for (int jj = 0; jj < 4; ++jj) { const f32x4 kk = *(LAS f32x4*)(k_s + t * 128 + kq * 16 + jj * 4), qq = *(LAS f32x4*)(q_s + t * 128 + kq * 16 + jj * 4);
#pragma unroll
                for (int e = 0; e < 4; ++e) { C[jj * 4 + e] = fp * C[jj * 4 + e] + iv * kk[e]; nn[jj * 4 + e] = fp * nn[jj * 4 + e] + ip * kk[e]; pn += C[jj * 4 + e] * qq[e]; pd += nn[jj * 4 + e] * qq[e]; } }
            pn = sum8(pn); pd = sum8(pd);
            if (kq == 0) o_s[t * 64 + v] = pn * __builtin_amdgcn_rcpf(fmaxf(fabsf(pd), scv.z));
        }
        __syncthreads();
        { const int slot = tid >> 3, pc = tid & 7; const LAS float* op = o_s + slot * 64 + pc * 8; const f32x4 a0 = *(const LAS f32x4*)op, a1 = *(const LAS f32x4*)(op + 4);
          u32x4 w; w.x = pk2(a0[0], a0[1]); w.y = pk2(a0[2], a0[3]); w.z = pk2(a1[0], a1[1]); w.w = pk2(a1[2], a1[3]);
          *(u32x4*)(Hd + (size_t)chain_row(b, dir, ci, slot) * 1024 + h * 256 + vs * 64 + pc * 8) = w; }
    }
#undef ML_LOAD
    __syncthreads();
}

__device__ __forceinline__ void hgrn_chain(LAS unsigned char* lds, int c, const bf16* P, const float* lb_logits, bf16* Oout) {
    const int vs = c & 1, dir = (c >> 1) & 1, h = (c >> 2) & 7, b = c >> 5;
    LAS float* q_s = (LAS float*)(lds + CH_Q); LAS float* f_s = (LAS float*)(lds + CH_K); LAS float* v_s = (LAS float*)(lds + CH_V); LAS float* o_s = (LAS float*)(lds + CH_O);
    const int tid = threadIdx.x, v = tid >> 3, kq = tid & 7;
    bf16* Od = Oout + (size_t)dir * DIRSZ;
    float lbv[8];
    { const int pc = tid & 15;
#pragma unroll
      for (int e = 0; e < 8; ++e) { const float l0 = lb_logits[h * 128 + pc * 8 + e], l1 = lb_logits[1024 + h * 128 + pc * 8 + e]; const float mx = fmaxf(l0, l1), e0 = __expf(l0 - mx), e1 = __expf(l1 - mx);
          const float p0 = e0 / (e0 + e1), p1 = e1 / (e0 + e1); lbv[e] = (p0 + p1) - p0; } }
    float S[16];
#pragma unroll
    for (int e = 0; e < 16; ++e) S[e] = 0.f;
    u32x4 rq[2], rf[2], rv;
#define HG_LOAD(ci_) do { \
        _Pragma("unroll") for (int i = 0; i < 2; ++i) { const int idx = tid + NTHR * i, slot = idx >> 4, pc = idx & 15; const bf16* rp = P + (size_t)chain_row(b, dir, (ci_), slot) * LDP1; \
            rq[i] = *(const u32x4*)(rp + h * 128 + pc * 8); rf[i] = *(const u32x4*)(rp + 1024 + dir * 1024 + h * 128 + pc * 8); } \
        { const int slot = tid >> 3, pc = tid & 7; rv = *(const u32x4*)(P + (size_t)chain_row(b, dir, (ci_), slot) * LDP1 + 3072 + h * 128 + vs * 64 + pc * 8); } } while (0)
    HG_LOAD(0);
    for (int ci = 0; ci < 68; ++ci) {
#pragma unroll
        for (int i = 0; i < 2; ++i) { const int idx = tid + NTHR * i, slot = idx >> 4, pc = idx & 15;
            float qv[8] = {bflo(rq[i].x), bfhi(rq[i].x), bflo(rq[i].y), bfhi(rq[i].y), bflo(rq[i].z), bfhi(rq[i].z), bflo(rq[i].w), bfhi(rq[i].w)};
            float fv[8] = {bflo(rf[i].x), bfhi(rf[i].x), bflo(rf[i].y), bfhi(rf[i].y), bflo(rf[i].z), bfhi(rf[i].z), bflo(rf[i].w), bfhi(rf[i].w)};
#pragma unroll
            for (int e = 0; e < 8; ++e) { qv[e] = siluf_(qv[e]); fv[e] = lbv[e] + (1.f - lbv[e]) * sigmoidf_(fv[e]); }
            *(LAS f32x4*)(q_s + slot * 128 + pc * 8) = (f32x4){qv[0], qv[1], qv[2], qv[3]}; *(LAS f32x4*)(q_s + slot * 128 + pc * 8 + 4) = (f32x4){qv[4], qv[5], qv[6], qv[7]};
            *(LAS f32x4*)(f_s + slot * 128 + pc * 8) = (f32x4){fv[0], fv[1], fv[2], fv[3]}; *(LAS f32x4*)(f_s + slot * 128 + pc * 8 + 4) = (f32x4){fv[4], fv[5], fv[6], fv[7]}; }
        { const int slot = tid >> 3, pc = tid & 7;
          float vv[8] = {bflo(rv.x), bfhi(rv.x), bflo(rv.y), bfhi(rv.y), bflo(rv.z), bfhi(rv.z), bflo(rv.w), bfhi(rv.w)};
#pragma unroll
          for (int e = 0; e < 8; ++e) vv[e] = siluf_(vv[e]);
          *(LAS f32x4*)(v_s + slot * 64 + pc * 8) = (f32x4){vv[0], vv[1], vv[2], vv[3]}; *(LAS f32x4*)(v_s + slot * 64 + pc * 8 + 4) = (f32x4){vv[4], vv[5], vv[6], vv[7]}; }
        __syncthreads();
        if (ci + 1 < 68) HG_LOAD(ci + 1);
        for (int t = 0; t < 64; ++t) {
            const float vt = v_s[t * 64 + v];
            float po = 0.f;
#pragma unroll
            for (int jj = 0; jj < 4; ++jj) { const f32x4 ff = *(LAS f32x4*)(f_s + t * 128 + kq * 16 + jj * 4), qq = *(LAS f32x4*)(q_s + t * 128 + kq * 16 + jj * 4);
#pragma unroll
                for (int e = 0; e < 4; ++e) { S[jj * 4 + e] = ff[e] * S[jj * 4 + e] + (1.f - ff[e]) * vt; po += S[jj * 4 + e] * qq[e]; } }
            po = sum8(po);
            if (kq == 0) o_s[t * 64 + v] = po;
        }
        __syncthreads();
        { const int slot = tid >> 3, pc = tid & 7; const LAS float* op = o_s + slot * 64 + pc * 8; const f32x4 a0 = *(const LAS f32x4*)op, a1 = *(const LAS f32x4*)(op + 4);
          u32x4 w; w.x = pk2(a0[0], a0[1]); w.y = pk2(a0[2], a0[3]); w.z = pk2(a1[0], a1[1]); w.w = pk2(a1[2], a1[3]);
          *(u32x4*)(Od + (size_t)chain_row(b, dir, ci, slot) * 1024 + h * 128 + vs * 64 + pc * 8) = w; }
    }
#undef HG_LOAD
    __syncthreads();
}

__device__ __forceinline__ void ssd_chain(LAS unsigned char* lds, int c, const bf16* XBC, const float* G, const float* dt_bias, const float* a_log, bf16* Yout) {
    const int dir = c & 1, h = (c >> 1) & 15, b = c >> 5, grp = h >> 3;
    LAS float* c_s = (LAS float*)(lds + CH_Q); LAS float* b_s = (LAS float*)(lds + CH_K); LAS float* x_s = (LAS float*)(lds + CH_V); LAS float* o_s = (LAS float*)(lds + CH_O);
    LAS f32x2* sc_s = (LAS f32x2*)(lds + CH_SC);
    const int tid = threadIdx.x, lane = tid & 63, wave = tid >> 6, p = tid >> 3, kq = tid & 7;
    bf16* Yd = Yout + (size_t)dir * DIRSZ;
    const float dtb = dt_bias[dir * 16 + h], Aneg = -__expf(a_log[dir * 16 + h]);
    float S[16];
#pragma unroll
    for (int e = 0; e < 16; ++e) S[e] = 0.f;
    u32x4 rc[2], rb[2], rx; float gdt = 0.f;
#define SD_LOAD(ci_) do { \
        _Pragma("unroll") for (int i = 0; i < 2; ++i) { const int idx = tid + NTHR * i, slot = idx >> 4, pc = idx & 15; const bf16* rp = XBC + (size_t)chain_row(b, dir, (ci_), slot) * 1536; \
            rb[i] = *(const u32x4*)(rp + 1024 + grp * 128 + pc * 8); rc[i] = *(const u32x4*)(rp + 1280 + grp * 128 + pc * 8); } \
        { const int slot = tid >> 3, pc = tid & 7; rx = *(const u32x4*)(XBC + (size_t)chain_row(b, dir, (ci_), slot) * 1536 + h * 64 + pc * 8); } \
        if (wave == 0) gdt = G[(size_t)chain_row(b, dir, (ci_), lane) * 32 + dir * 16 + h]; } while (0)
    SD_LOAD(0);
    for (int ci = 0; ci < 68; ++ci) {
#pragma unroll
        for (int i = 0; i < 2; ++i) { const int idx = tid + NTHR * i, slot = idx >> 4, pc = idx & 15; st8f(c_s + slot * 128 + pc * 8, rc[i], 1.f); st8f(b_s + slot * 128 + pc * 8, rb[i], 1.f); }
        { const int slot = tid >> 3, pc = tid & 7; st8f(x_s + slot * 64 + pc * 8, rx, 1.f); }
        if (wave == 0) { const float dt = softplusf_(gdt + dtb); sc_s[lane] = (f32x2){__expf(dt * Aneg), dt}; }
        __syncthreads();
        if (ci + 1 < 68) SD_LOAD(ci + 1);
        for (int t = 0; t < 64; ++t) {
            const f32x2 scv = sc_s[t];
            const float da = scv.x, dx = scv.y * x_s[t * 64 + p];
            float py = 0.f;
#pragma unroll
            for (int jj = 0; jj < 4; ++jj) { const f32x4 bb = *(LAS f32x4*)(b_s + t * 128 + kq * 16 + jj * 4), cc = *(LAS f32x4*)(c_s + t * 128 + kq * 16 + jj * 4);
#pragma unroll
                for (int e = 0; e < 4; ++e) { S[jj * 4 + e] = da * S[jj * 4 + e] + dx * bb[e]; py += S[jj * 4 + e] * cc[e]; } }
            py = sum8(py);
            if (kq == 0) o_s[t * 64 + p] = py;
        }
        __syncthreads();
        { const int slot = tid >> 3, pc = tid & 7; const LAS float* op = o_s + slot * 64 + pc * 8; const f32x4 a0 = *(const LAS f32x4*)op, a1 = *(const LAS f32x4*)(op + 4);
          u32x4 w; w.x = pk2(a0[0], a0[1]); w.y = pk2(a0[2], a0[3]); w.z = pk2(a1[0], a1[1]); w.w = pk2(a1[2], a1[3]);
          *(u32x4*)(Yd + (size_t)chain_row(b, dir, ci, slot) * 1024 + h * 64 + pc * 8) = w; }
    }
#undef SD_LOAD
    __syncthreads();
}


constexpr int PQ = 136, PS = 72;
constexpr int L_QX = 0, L_KX = 17408, L_KUT = 34816, L_VT = 53248, L_PM = 64768, L_ST0 = 73984, L_ST1 = 95744, L_SC = 117504, L_LG = 121600, L_SEG = 155392;
constexpr int LGP = 132;
typedef LAS bf16* lbf;
__device__ __forceinline__ float bfe(const u32x4& u, int e) { const unsigned w = u[e >> 1]; return (e & 1) ? bfhi(w) : bflo(w); }
__device__ __forceinline__ unsigned short bfraw(const u32x4& u, int e) { const unsigned w = u[e >> 1]; return (unsigned short)((e & 1) ? (w >> 16) : (w & 0xffffu)); }
__device__ __forceinline__ bf16x8 ldfrag(const LAS bf16* p) { return *(const LAS bf16x8*)p; }
__device__ __forceinline__ u32x2 pack4(const f32x4& v) { u32x2 w; w.x = pk2(v[0], v[1]); w.y = pk2(v[2], v[3]); return w; }

template <class PF>
__device__ __forceinline__ void chunk_scores(const LAS bf16* kx, const LAS bf16* qx, LAS bf16* pm, int wave, int lane, PF pf) {
    const int sb = wave >> 1, li = lane & 15, quad = lane >> 4;
    bf16x8 af[4];
#pragma unroll
    for (int ks = 0; ks < 4; ++ks) af[ks] = ldfrag(kx + (sb * 16 + li) * PQ + ks * 32 + quad * 8);
#pragma unroll
    for (int tt = 0; tt < 2; ++tt) {
        const int tb = (wave & 1) * 2 + tt, t = tb * 16 + li, s0 = sb * 16 + quad * 4;
        f32x4 v = (f32x4){0.f, 0.f, 0.f, 0.f};
        if (sb <= tb) {
            f32x4 acc = (f32x4){0.f, 0.f, 0.f, 0.f};
#pragma unroll
            for (int ks = 0; ks < 4; ++ks) acc = __builtin_amdgcn_mfma_f32_16x16x32_bf16(af[ks], ldfrag(qx + (tb * 16 + li) * PQ + ks * 32 + quad * 8), acc, 0, 0, 0);
            const f32x4 r = pf(acc, s0, t);
#pragma unroll
            for (int i = 0; i < 4; ++i) v[i] = (s0 + i <= t) ? r[i] : 0.f;
        }
        *(LAS u32x2*)(pm + t * PS + s0) = pack4(v);
    }
}
__device__ __forceinline__ void out_block(const LAS bf16* vt, const LAS bf16* stt, const bf16x8 (&bp)[2], const bf16x8 (&bq)[4], int dvb, int li, int quad, f32x4& a1, f32x4& a2) {
    a1 = (f32x4){0.f, 0.f, 0.f, 0.f}; a2 = (f32x4){0.f, 0.f, 0.f, 0.f};
#pragma unroll
    for (int ks = 0; ks < 2; ++ks) a1 = __builtin_amdgcn_mfma_f32_16x16x32_bf16(ldfrag(vt + (dvb * 16 + li) * PS + ks * 32 + quad * 8), bp[ks], a1, 0, 0, 0);
#pragma unroll
    for (int ks = 0; ks < 4; ++ks) a2 = __builtin_amdgcn_mfma_f32_16x16x32_bf16(ldfrag(stt + (dvb * 16 + li) * PQ + ks * 32 + quad * 8), bq[ks], a2, 0, 0, 0);
}
template <class PF>
__device__ __forceinline__ void chunk_scores_frag(const LAS bf16* kx, const bf16x8 (&bq)[4], int tb, int li, int quad, bf16x8 (&bp)[2], PF pf) {
    const int t = tb * 16 + li;
#pragma unroll
    for (int sp = 0; sp < 2; ++sp) { u32x4 w;
#pragma unroll
        for (int hf = 0; hf < 2; ++hf) { const int sb = 2 * sp + hf, s0 = sb * 16 + quad * 4; f32x4 v = (f32x4){0.f, 0.f, 0.f, 0.f};
            if (sb <= tb) { f32x4 acc = (f32x4){0.f, 0.f, 0.f, 0.f};
#pragma unroll
                for (int ks = 0; ks < 4; ++ks) acc = __builtin_amdgcn_mfma_f32_16x16x32_bf16(ldfrag(kx + (sb * 16 + li) * PQ + ks * 32 + quad * 8), bq[ks], acc, 0, 0, 0);
                const f32x4 r = pf(acc, s0, t);
#pragma unroll
                for (int i = 0; i < 4; ++i) v[i] = (s0 + i <= t) ? r[i] : 0.f; }
            w[hf * 2] = pk2(v[0], v[1]); w[hf * 2 + 1] = pk2(v[2], v[3]); }
        bp[sp] = __builtin_bit_cast(bf16x8, w); }
}
__device__ __forceinline__ void out_block2(const LAS bf16* vt, const LAS bf16* stt, const bf16x8 (&bp)[2], const bf16x8 (&bq)[4], int dvb, int li, int quad, f32x4& a1, f32x4& a2) {
    a1 = (f32x4){0.f, 0.f, 0.f, 0.f}; a2 = (f32x4){0.f, 0.f, 0.f, 0.f};
#pragma unroll
    for (int sp = 0; sp < 2; ++sp) { const u32x2 lo = *(const LAS u32x2*)(vt + (dvb * 16 + li) * PS + sp * 32 + quad * 4), hi = *(const LAS u32x2*)(vt + (dvb * 16 + li) * PS + sp * 32 + 16 + quad * 4);
        u32x4 av; av.x = lo.x; av.y = lo.y; av.z = hi.x; av.w = hi.y;
        a1 = __builtin_amdgcn_mfma_f32_16x16x32_bf16(__builtin_bit_cast(bf16x8, av), bp[sp], a1, 0, 0, 0); }
#pragma unroll
    for (int ks = 0; ks < 4; ++ks) a2 = __builtin_amdgcn_mfma_f32_16x16x32_bf16(ldfrag(stt + (dvb * 16 + li) * PQ + ks * 32 + quad * 8), bq[ks], a2, 0, 0, 0);
}
template <int NDVB, class DF>
__device__ __forceinline__ void chunk_state(const LAS bf16* kut, const LAS bf16* vt, LAS bf16* sttw, f32x4 (&St)[NDVB], int wave, int lane, DF df) {
    const int li = lane & 15, quad = lane >> 4, dk0 = wave * 16 + quad * 4;
    bf16x8 ak[2];
#pragma unroll
    for (int ks = 0; ks < 2; ++ks) ak[ks] = ldfrag(kut + (wave * 16 + li) * PS + ks * 32 + quad * 8);
    const f32x4 dec = df(dk0);
#pragma unroll
    for (int dvb = 0; dvb < NDVB; ++dvb) {
        St[dvb] *= dec;
#pragma unroll
        for (int ks = 0; ks < 2; ++ks) St[dvb] = __builtin_amdgcn_mfma_f32_16x16x32_bf16(ak[ks], ldfrag(vt + (dvb * 16 + li) * PS + ks * 32 + quad * 8), St[dvb], 0, 0, 0);
        *(LAS u32x2*)(sttw + (dvb * 16 + li) * PQ + dk0) = pack4(St[dvb]);
    }
}

__device__ __forceinline__ void ssd_chain2(LAS unsigned char* lds, int c, const bf16* XBC, const float* G, const float* dt_bias, const float* a_log, bf16* Yout) {
    const int dir = c & 1, h = (c >> 1) & 15, b = c >> 5, grp = h >> 3;
    lbf qx = (lbf)(lds + L_QX), kx = (lbf)(lds + L_KX), kut = (lbf)(lds + L_KUT), vt = (lbf)(lds + L_VT), pm = (lbf)(lds + L_PM), st0 = (lbf)(lds + L_ST0), st1 = (lbf)(lds + L_ST1);
    LAS float* scl = (LAS float*)(lds + L_SC);
    const int tid = threadIdx.x, lane = tid & 63, wave = tid >> 6, li = lane & 15, quad = lane >> 4;
    bf16* Yd = Yout + (size_t)dir * DIRSZ;
    const float dtb = dt_bias[dir * 16 + h], Aneg = -__expf(a_log[dir * 16 + h]);
    f32x4 St[4];
#pragma unroll
    for (int e = 0; e < 4; ++e) St[e] = (f32x4){0.f, 0.f, 0.f, 0.f};
    for (int i = tid; i < 64 * PQ / 2; i += NTHR) ((LAS unsigned*)st0)[i] = 0u;
    u32x4 rc[2][2], rb[2][2], rx[2]; float gdt[2];
#define SD_LOAD(S_, ci_) do { \
        _Pragma("unroll") for (int i = 0; i < 2; ++i) { const int wi_ = wave + 8 * i, slot = (lane & 31) | ((wi_ & 1) << 5), pc = (lane >> 5) | ((wi_ >> 1) << 1); const bf16* rp = XBC + (size_t)chain_row(b, dir, (ci_), slot) * 1536; \
            rb[S_][i] = *(const u32x4*)(rp + 1024 + grp * 128 + pc * 8); rc[S_][i] = *(const u32x4*)(rp + 1280 + grp * 128 + pc * 8); } \
        { const int slot = (lane & 31) | ((wave & 1) << 5), pc = (lane >> 5) | ((wave >> 1) << 1); rx[S_] = *(const u32x4*)(XBC + (size_t)chain_row(b, dir, (ci_), slot) * 1536 + h * 64 + pc * 8); } \
        gdt[S_] = G[(size_t)chain_row(b, dir, (ci_), lane) * 32 + dir * 16 + h]; } while (0)
    SD_LOAD(0, 0);
    for (int c2 = 0; c2 < 34; ++c2) {
#pragma unroll
      for (int u = 0; u < 2; ++u) { const int ci = 2 * c2 + u;
        if (ci + 1 < 68) SD_LOAD(u ^ 1, ci + 1);
        const float dt = softplusf_(gdt[u] + dtb);
        const float acum = wave_scan_add(dt * Aneg);
        const float acl = lane63(acum);
        const float wv = __expf(acl - acum) * dt, dec = __expf(acl);
        if (wave == 0) { scl[lane] = acum; scl[64 + lane] = dt; scl[128 + lane] = __expf(acum); }
#pragma unroll
        for (int i = 0; i < 2; ++i) { const int wi_ = wave + 8 * i, slot = (lane & 31) | ((wi_ & 1) << 5), pc = (lane >> 5) | ((wi_ >> 1) << 1);
            *(LAS u32x4*)(qx + slot * PQ + pc * 8) = rc[u][i]; *(LAS u32x4*)(kx + slot * PQ + pc * 8) = rb[u][i];
            const float ws = __shfl(wv, slot);
#pragma unroll
            for (int e = 0; e < 8; ++e) kut[(pc * 8 + e) * PS + slot] = (bf16)f2bf(bfe(rb[u][i], e) * ws); }
        { const int slot = (lane & 31) | ((wave & 1) << 5), pc = (lane >> 5) | ((wave >> 1) << 1);
#pragma unroll
          for (int e = 0; e < 8; ++e) vt[(pc * 8 + e) * PS + slot] = bfraw(rx[u], e); }
        __syncthreads();
#define SCORE_FN_1 [=](const f32x4& acc, int s0, int t) { const float at = scl[t]; const f32x4 as = *(const LAS f32x4*)(scl + s0), ds = *(const LAS f32x4*)(scl + 64 + s0); \
            return (f32x4){acc[0] * __expf(at - as[0]) * ds[0], acc[1] * __expf(at - as[1]) * ds[1], acc[2] * __expf(at - as[2]) * ds[2], acc[3] * __expf(at - as[3]) * ds[3]}; }
        if (ci >= 4)
        { const lbf stt = (ci & 1) ? st1 : st0; const int tb = wave >> 1, t = tb * 16 + li;
          bf16x8 bp[2], bq[4];
#pragma unroll
          for (int ks = 0; ks < 4; ++ks) bq[ks] = ldfrag(qx + t * PQ + ks * 32 + quad * 8);
          chunk_scores_frag(kx, bq, tb, li, quad, bp, SCORE_FN_1);
          const float ea = scl[128 + t]; bf16* yp = Yd + (size_t)chain_row(b, dir, ci, t) * 1024 + h * 64 + quad * 4;
#pragma unroll
          for (int d2 = 0; d2 < 2; ++d2) { const int dvb = (wave & 1) * 2 + d2; f32x4 a1, a2; out_block2(vt, stt, bp, bq, dvb, li, quad, a1, a2);
              *(u32x2*)(yp + dvb * 16) = pack4(a1 + ea * a2); } }
        chunk_state<4>(kut, vt, (ci & 1) ? st0 : st1, St, wave, lane, [=](int) { return (f32x4){dec, dec, dec, dec}; });
        __syncthreads();
      }
    }
#undef SD_LOAD
}

__device__ __forceinline__ void hgrn_chain2(LAS unsigned char* lds, int c, const bf16* P, const float* lb_logits, bf16* Oout) {
    const int vs = c & 1, dir = (c >> 1) & 1, h = (c >> 2) & 7, b = c >> 5;
    lbf qx = (lbf)(lds + L_QX), kx = (lbf)(lds + L_KX), kut = (lbf)(lds + L_KUT), vt = (lbf)(lds + L_VT), pm = (lbf)(lds + L_PM), st0 = (lbf)(lds + L_ST0), st1 = (lbf)(lds + L_ST1);
    LAS float* egl = (LAS float*)(lds + L_SC); LAS float* lg = (LAS float*)(lds + L_LG); LAS float* seg = (LAS float*)(lds + L_SEG);
    const int tid = threadIdx.x, lane = tid & 63, wave = tid >> 6, li = lane & 15, quad = lane >> 4;
    bf16* Od = Oout + (size_t)dir * DIRSZ;
    float lbv[2][8];
#pragma unroll
    for (int i = 0; i < 2; ++i) { const int wi_ = wave + 8 * i, pc = (lane >> 5) | ((wi_ >> 1) << 1);
#pragma unroll
      for (int e = 0; e < 8; ++e) { const float l0 = lb_logits[h * 128 + pc * 8 + e], l1 = lb_logits[1024 + h * 128 + pc * 8 + e]; const float mx = fmaxf(l0, l1), e0 = __expf(l0 - mx), e1 = __expf(l1 - mx);
          const float p0 = e0 / (e0 + e1), p1 = e1 / (e0 + e1); lbv[i][e] = (p0 + p1) - p0; } }
    f32x4 St[4];
#pragma unroll
    for (int e = 0; e < 4; ++e) St[e] = (f32x4){0.f, 0.f, 0.f, 0.f};
    for (int i = tid; i < 64 * PQ / 2; i += NTHR) ((LAS unsigned*)st0)[i] = 0u;
    u32x4 rq[2][2], rf[2][2], rv[2];
#define HG_LOAD(S_, ci_) do { \
        _Pragma("unroll") for (int i = 0; i < 2; ++i) { const int wi_ = wave + 8 * i, slot = (lane & 31) | ((wi_ & 1) << 5), pc = (lane >> 5) | ((wi_ >> 1) << 1); const bf16* rp = P + (size_t)chain_row(b, dir, (ci_), slot) * LDP1; \
            rq[S_][i] = *(const u32x4*)(rp + h * 128 + pc * 8); rf[S_][i] = *(const u32x4*)(rp + 1024 + dir * 1024 + h * 128 + pc * 8); } \
        { const int slot = (lane & 31) | ((wave & 1) << 5), pc = (lane >> 5) | ((wave >> 1) << 1); rv[S_] = *(const u32x4*)(P + (size_t)chain_row(b, dir, (ci_), slot) * LDP1 + 3072 + h * 128 + vs * 64 + pc * 8); } } while (0)
    HG_LOAD(0, 0);
    for (int c2 = 0; c2 < 34; ++c2) {
#pragma unroll
      for (int u = 0; u < 2; ++u) { const int ci = 2 * c2 + u;
        if (ci + 1 < 68) HG_LOAD(u ^ 1, ci + 1);
        float qs[2][8], kf[2][8];
#pragma unroll
        for (int i = 0; i < 2; ++i) { const int wi_ = wave + 8 * i, slot = (lane & 31) | ((wi_ & 1) << 5), pc = (lane >> 5) | ((wi_ >> 1) << 1); float lgv[8];
#pragma unroll
            for (int e = 0; e < 8; ++e) { qs[i][e] = siluf_(bfe(rq[u][i], e)); const float f = lbv[i][e] + (1.f - lbv[i][e]) * sigmoidf_(bfe(rf[u][i], e)); kf[i][e] = 1.f - f; lgv[e] = f; }
            const int pcs = pc ^ ((slot >> 4) & 3);
            *(LAS f32x4*)(lg + slot * LGP + pcs * 8) = (f32x4){lgv[0], lgv[1], lgv[2], lgv[3]}; *(LAS f32x4*)(lg + slot * LGP + pcs * 8 + 4) = (f32x4){lgv[4], lgv[5], lgv[6], lgv[7]}; }
        { const int slot = (lane & 31) | ((wave & 1) << 5), pc = (lane >> 5) | ((wave >> 1) << 1);
#pragma unroll
          for (int e = 0; e < 8; ++e) vt[(pc * 8 + e) * PS + slot] = (bf16)f2bf(siluf_(bfe(rv[u], e))); }
        __syncthreads();
        { const int dk = tid >> 2, sg = tid & 3, dkc = dk ^ (sg << 3); float pr[16]; float run = 1.f;
#pragma unroll
          for (int i = 0; i < 16; ++i) { run *= lg[(sg * 16 + i) * LGP + dkc]; pr[i] = run; }
          const float ta = dppmov<0x90, 0xF>(1.f, run), tb2 = dppmov<0x40, 0xF>(1.f, run), tc = dppmov<0x00, 0xF>(1.f, run);
          const float off = (sg >= 1 ? ta : 1.f) * (sg >= 2 ? tb2 : 1.f) * (sg >= 3 ? tc : 1.f);
#pragma unroll
          for (int i = 0; i < 16; ++i) lg[(sg * 16 + i) * LGP + dkc] = pr[i] * off;
          if (sg == 3) egl[dk] = run * off; }
        __syncthreads();
#pragma unroll
        for (int i = 0; i < 2; ++i) { const int wi_ = wave + 8 * i, slot = (lane & 31) | ((wi_ & 1) << 5), pc = (lane >> 5) | ((wi_ >> 1) << 1);
            float gv[8], gl[8];
            const int pcs = pc ^ ((slot >> 4) & 3);
#pragma unroll
            for (int hh = 0; hh < 2; ++hh) { const f32x4 l = *(const LAS f32x4*)(lg + slot * LGP + pcs * 8 + hh * 4), g4 = *(const LAS f32x4*)(egl + pc * 8 + hh * 4);
#pragma unroll
                for (int e = 0; e < 4; ++e) { gv[hh * 4 + e] = l[e]; gl[hh * 4 + e] = g4[e]; } }
            u32x4 wq, wk;
#pragma unroll
            for (int e = 0; e < 4; ++e) { const float r0 = __builtin_amdgcn_rcpf(gv[2 * e]), r1 = __builtin_amdgcn_rcpf(gv[2 * e + 1]);
                wq[e] = pk2(qs[i][2 * e] * gv[2 * e], qs[i][2 * e + 1] * gv[2 * e + 1]); wk[e] = pk2(kf[i][2 * e] * r0, kf[i][2 * e + 1] * r1);
                kf[i][2 * e] *= gl[2 * e] * r0; kf[i][2 * e + 1] *= gl[2 * e + 1] * r1; }
            *(LAS u32x4*)(qx + slot * PQ + pc * 8) = wq; *(LAS u32x4*)(kx + slot * PQ + pc * 8) = wk;
#pragma unroll
            for (int e = 0; e < 8; ++e) kut[(pc * 8 + e) * PS + slot] = (bf16)f2bf(kf[i][e]); }
        __syncthreads();
#define SCORE_FN_2 [=](const f32x4& acc, int, int) { return acc; }
        if (ci >= 4)
        { const lbf stt = (ci & 1) ? st1 : st0; const int tb = wave >> 1, t = tb * 16 + li;
          bf16x8 bp[2], bq[4];
#pragma unroll
          for (int ks = 0; ks < 4; ++ks) bq[ks] = ldfrag(qx + t * PQ + ks * 32 + quad * 8);
          chunk_scores_frag(kx, bq, tb, li, quad, bp, SCORE_FN_2);
          bf16* yp = Od + (size_t)chain_row(b, dir, ci, t) * 1024 + h * 128 + vs * 64 + quad * 4;
#pragma unroll
          for (int d2 = 0; d2 < 2; ++d2) { const int dvb = (wave & 1) * 2 + d2; f32x4 a1, a2; out_block2(vt, stt, bp, bq, dvb, li, quad, a1, a2);
              *(u32x2*)(yp + dvb * 16) = pack4(a1 + a2); } }
        chunk_state<4>(kut, vt, (ci & 1) ? st0 : st1, St, wave, lane, [=](int dk0) { return *(const LAS f32x4*)(egl + dk0); });
        __syncthreads();
      }
    }
#undef HG_LOAD
}

__device__ __forceinline__ void mlstm_chain2(LAS unsigned char* lds, int c, const bf16* P, const float* G, const float* gate_bias, bf16* Hout) {
    const int vs = c & 3, dir = (c >> 2) & 1, h = (c >> 3) & 3, b = c >> 5;
    lbf qx = (lbf)(lds + L_QX), kx = (lbf)(lds + L_KX), kut = (lbf)(lds + L_KUT), vt = (lbf)(lds + L_VT), pm = (lbf)(lds + L_PM), st0 = (lbf)(lds + L_ST0), st1 = (lbf)(lds + L_ST1);
    LAS float* scl = (LAS float*)(lds + L_SC);
    const int tid = threadIdx.x, lane = tid & 63, wave = tid >> 6, li = lane & 15, quad = lane >> 4;
    bf16* Hd = Hout + (size_t)dir * DIRSZ;
    const float gb_i = gate_bias[(2 * dir) * 4 + h], gb_f = gate_bias[(2 * dir + 1) * 4 + h];
    f32x4 St[5];
#pragma unroll
    for (int e = 0; e < 5; ++e) St[e] = (f32x4){0.f, 0.f, 0.f, 0.f};
    for (int i = tid; i < 80 * PQ / 2; i += NTHR) ((LAS unsigned*)st0)[i] = 0u;
    for (int i = tid; i < 16 * PS; i += NTHR) vt[64 * PS + i] = (i < 64) ? (bf16)0x3F80u : (bf16)0u;
    float mprev = 0.f;
    u32x4 rq[2][2], rk[2][2], rv[2]; float gi[2], gf[2];
#define ML_LOAD(S_, ci_) do { \
        _Pragma("unroll") for (int i = 0; i < 2; ++i) { const int wi_ = wave + 8 * i, slot = (lane & 31) | ((wi_ & 1) << 5), pc = (lane >> 5) | ((wi_ >> 1) << 1); const bf16* rp = P + (size_t)chain_row(b, dir, (ci_), slot) * LDP0; \
            rq[S_][i] = *(const u32x4*)(rp + 3072 + h * 128 + pc * 8); rk[S_][i] = *(const u32x4*)(rp + 3584 + h * 128 + pc * 8); } \
        { const int slot = (lane & 31) | ((wave & 1) << 5), pc = (lane >> 5) | ((wave >> 1) << 1); rv[S_] = *(const u32x4*)(P + (size_t)chain_row(b, dir, (ci_), slot) * LDP0 + 4096 + h * 256 + vs * 64 + pc * 8); } \
        { const float* gp = G + (size_t)chain_row(b, dir, (ci_), lane) * 32; gi[S_] = gp[(2 * dir) * 4 + h]; gf[S_] = gp[(2 * dir + 1) * 4 + h]; } } while (0)
    ML_LOAD(0, 0);
    for (int c2 = 0; c2 < 34; ++c2) {
#pragma unroll
      for (int u = 0; u < 2; ++u) { const int ci = 2 * c2 + u;
        if (ci + 1 < 68) ML_LOAD(u ^ 1, ci + 1);
        const float li_ = gi[u] + gb_i, lf_ = logsigmoidf_(gf[u] + gb_f);
        const float F = wave_scan_add(lf_);
        const float pmx = wave_scan_max(li_ - F);
        const float mt = F + fmaxf(mprev, pmx);
        const float mnew = lane63(mt), F63 = lane63(F);
        const float wv = __expf(F63 - F + li_ - mnew), adec = __expf(F63 + mprev - mnew);
        if (wave == 0) { scl[lane] = F - mt; scl[64 + lane] = li_ - F; scl[128 + lane] = __expf(F + mprev - mt); scl[192 + lane] = __expf(-mt); }
        mprev = mnew;
#pragma unroll
        for (int i = 0; i < 2; ++i) { const int wi_ = wave + 8 * i, slot = (lane & 31) | ((wi_ & 1) << 5), pc = (lane >> 5) | ((wi_ >> 1) << 1);
            u32x4 wq;
#pragma unroll
            for (int e = 0; e < 4; ++e) wq[e] = pk2(bflo(rq[u][i][e]) * 0.08838834764831845f, bfhi(rq[u][i][e]) * 0.08838834764831845f);
            *(LAS u32x4*)(qx + slot * PQ + pc * 8) = wq; *(LAS u32x4*)(kx + slot * PQ + pc * 8) = rk[u][i];
            const float ws = __shfl(wv, slot);
#pragma unroll
            for (int e = 0; e < 8; ++e) kut[(pc * 8 + e) * PS + slot] = (bf16)f2bf(bfe(rk[u][i], e) * ws); }
        { const int slot = (lane & 31) | ((wave & 1) << 5), pc = (lane >> 5) | ((wave >> 1) << 1);
#pragma unroll
          for (int e = 0; e < 8; ++e) vt[(pc * 8 + e) * PS + slot] = bfraw(rv[u], e); }
        __syncthreads();
#define SCORE_FN_3 [=](const f32x4& acc, int s0, int t) { const float rt = scl[t]; const f32x4 cs = *(const LAS f32x4*)(scl + 64 + s0); \
            return (f32x4){acc[0] * __expf(rt + cs[0]), acc[1] * __expf(rt + cs[1]), acc[2] * __expf(rt + cs[2]), acc[3] * __expf(rt + cs[3])}; }
        { const lbf stt = (ci & 1) ? st1 : st0; const int tb = wave >> 1, t = tb * 16 + li;
          bf16x8 bp[2], bq[4];
#pragma unroll
          for (int ks = 0; ks < 4; ++ks) bq[ks] = ldfrag(qx + t * PQ + ks * 32 + quad * 8);
          chunk_scores_frag(kx, bq, tb, li, quad, bp, SCORE_FN_3);
          const float wi = scl[128 + t], em = scl[192 + t];
          f32x4 a1, a2; out_block2(vt, stt, bp, bq, 4, li, quad, a1, a2);
          const float den = __shfl(a1[0] + wi * a2[0], li);
          const float rden = __builtin_amdgcn_rcpf(fmaxf(fabsf(den), em));
          bf16* yp = Hd + (size_t)chain_row(b, dir, ci, t) * 1024 + h * 256 + vs * 64 + quad * 4;
#pragma unroll
          for (int d2 = 0; d2 < 2; ++d2) { const int dvb = (wave & 1) * 2 + d2; out_block2(vt, stt, bp, bq, dvb, li, quad, a1, a2);
              *(u32x2*)(yp + dvb * 16) = pack4((a1 + wi * a2) * rden); } }
        chunk_state<5>(kut, vt, (ci & 1) ? st0 : st1, St, wave, lane, [=](int) { return (f32x4){adec, adec, adec, adec}; });
        __syncthreads();
      }
    }
#undef ML_LOAD
}

__device__ __forceinline__ void unpack8(const u32x4& u, float* f) { f[0] = bflo(u.x); f[1] = bfhi(u.x); f[2] = bflo(u.y); f[3] = bfhi(u.y); f[4] = bflo(u.z); f[5] = bfhi(u.z); f[6] = bflo(u.w); f[7] = bfhi(u.w); }
__device__ __forceinline__ u32x4 pack8(const float* f) { u32x4 w; w.x = pk2(f[0], f[1]); w.y = pk2(f[2], f[3]); w.z = pk2(f[4], f[5]); w.w = pk2(f[6], f[7]); return w; }
__device__ __forceinline__ void phase_post0(const bf16* Hdir, const bf16* P, const float* ml_gain, bf16* Y) {
    const int lane = threadIdx.x & 63, wave = threadIdx.x >> 6, c0 = lane * 16;
    const int gw = blockIdx.x * NWAVES + wave, NGW = gridDim.x * NWAVES;
    float g[16];
#pragma unroll
    for (int q = 0; q < 4; ++q) { const f32x4 t = *(const f32x4*)(ml_gain + c0 + 4 * q); g[4 * q] = t[0]; g[4 * q + 1] = t[1]; g[4 * q + 2] = t[2]; g[4 * q + 3] = t[3]; }
    for (int row0 = gw; row0 < MTOT; row0 += 4 * NGW) {
        u32x4 hf[4][2], hb[4][2], og[4][2];
#pragma unroll
        for (int k = 0; k < 4; ++k) { const int row = row0 + k * NGW;
            if (row < MTOT) {
#pragma unroll
                for (int q = 0; q < 2; ++q) { hf[k][q] = *(const u32x4*)(Hdir + (size_t)row * 1024 + c0 + 8 * q); hb[k][q] = *(const u32x4*)(Hdir + DIRSZ + (size_t)row * 1024 + c0 + 8 * q);
                    og[k][q] = *(const u32x4*)(P + (size_t)row * LDP0 + 5120 + c0 + 8 * q); } } }
#pragma unroll
        for (int k = 0; k < 4; ++k) { const int row = row0 + k * NGW;
            if (row < MTOT) {
                float hv[16], t1[8], t2[8], ov[16]; float ss = 0.f;
#pragma unroll
                for (int q = 0; q < 2; ++q) { unpack8(hf[k][q], t1); unpack8(hb[k][q], t2); unpack8(og[k][q], ov + 8 * q);
#pragma unroll
                    for (int e = 0; e < 8; ++e) { hv[8 * q + e] = t1[e] + t2[e]; ss += hv[8 * q + e] * hv[8 * q + e]; } }
                ss = sum8(ss); ss += __shfl_xor(ss, 8);
                const float r = __builtin_amdgcn_rsqf(ss * (1.f / 256.f) + EPS);
#pragma unroll
                for (int e = 0; e < 16; ++e) hv[e] = hv[e] * r * g[e] * sigmoidf_(ov[e]);
                *(u32x4*)(Y + (size_t)row * DM + 1024 + c0) = pack8(hv); *(u32x4*)(Y + (size_t)row * DM + 1024 + c0 + 8) = pack8(hv + 8);
            } }
    }
}
__device__ __forceinline__ void phase_conv(const bf16* P, const float* conv_w, const float* conv_b, bf16* XBC) {
    const int NITEM = MTOT * 192, stride = gridDim.x * NTHR;
    for (int it0 = blockIdx.x * NTHR + threadIdx.x; it0 < NITEM; it0 += 2 * stride) {
        u32x4 u[2][5];
#pragma unroll
        for (int k = 0; k < 2; ++k) { const int it = it0 + k * stride;
            if (it < NITEM) { const int row = it / 192, c0 = (it % 192) * 8;
                int t, T, base;
                if (row < MLAT) { t = row & (SEQ - 1); T = SEQ; base = row - t; } else { t = (row - MLAT) & (CTXL - 1); T = CTXL; base = row - t; }
#pragma unroll
                for (int j = 0; j < 5; ++j) { const int tt = t + j - 2;
                    u[k][j] = (tt >= 0 && tt < T) ? *(const u32x4*)(P + (size_t)(base + tt) * LDP1 + 6144 + c0) : (u32x4){0u, 0u, 0u, 0u}; } } }
#pragma unroll
        for (int k = 0; k < 2; ++k) { const int it = it0 + k * stride;
            if (it < NITEM) { const int row = it / 192, c0 = (it % 192) * 8;
                float acc[8];
                { const f32x4 b0 = *(const f32x4*)(conv_b + c0), b1 = *(const f32x4*)(conv_b + c0 + 4);
#pragma unroll
                  for (int e = 0; e < 4; ++e) { acc[e] = b0[e]; acc[4 + e] = b1[e]; } }
#pragma unroll
                for (int j = 0; j < 5; ++j) { const u32x4 uu = u[k][j];
                    const f32x4 w0 = *(const f32x4*)(conv_w + j * 1536 + c0), w1 = *(const f32x4*)(conv_w + j * 1536 + c0 + 4);
                    acc[0] += w0[0] * bflo(uu.x); acc[1] += w0[1] * bfhi(uu.x); acc[2] += w0[2] * bflo(uu.y); acc[3] += w0[3] * bfhi(uu.y);
                    acc[4] += w1[0] * bflo(uu.z); acc[5] += w1[1] * bfhi(uu.z); acc[6] += w1[2] * bflo(uu.w); acc[7] += w1[3] * bfhi(uu.w); }
                u32x4 w; w.x = pk2(siluf_(acc[0]), siluf_(acc[1])); w.y = pk2(siluf_(acc[2]), siluf_(acc[3])); w.z = pk2(siluf_(acc[4]), siluf_(acc[5])); w.w = pk2(siluf_(acc[6]), siluf_(acc[7]));
                *(u32x4*)(XBC + (size_t)row * 1536 + c0) = w; } }
    }
}
__device__ __forceinline__ void phase_post1(const bf16* Odir, const bf16* Ydir, const bf16* P, const bf16* XBC, const float* hg_gain, const float* d_skip, const float* ssd_gain, bf16* Y) {
    const int lane = threadIdx.x & 63, wave = threadIdx.x >> 6, c0 = lane * 16;
    const int gw = blockIdx.x * NWAVES + wave, NGW = gridDim.x * NWAVES;
    float hg[16], sg[16];
#pragma unroll
    for (int q = 0; q < 4; ++q) { const f32x4 t = *(const f32x4*)(hg_gain + c0 + 4 * q), u = *(const f32x4*)(ssd_gain + c0 + 4 * q);
#pragma unroll
        for (int e = 0; e < 4; ++e) { hg[4 * q + e] = t[e]; sg[4 * q + e] = u[e]; } }
    const float ds = d_skip[c0 >> 6];
    for (int row = gw; row < MLAT; row += NGW) {
        u32x4 of[2], ob[2], og[2], yf[2], yb[2], xv[2], zv[2];
#pragma unroll
        for (int q = 0; q < 2; ++q) {
            of[q] = *(const u32x4*)(Odir + (size_t)row * 1024 + c0 + 8 * q); ob[q] = *(const u32x4*)(Odir + DIRSZ + (size_t)row * 1024 + c0 + 8 * q);
            og[q] = *(const u32x4*)(P + (size_t)row * LDP1 + 4096 + c0 + 8 * q);
            yf[q] = *(const u32x4*)(Ydir + (size_t)row * 1024 + c0 + 8 * q); yb[q] = *(const u32x4*)(Ydir + DIRSZ + (size_t)row * 1024 + c0 + 8 * q);
            xv[q] = *(const u32x4*)(XBC + (size_t)row * 1536 + c0 + 8 * q); zv[q] = *(const u32x4*)(P + (size_t)row * LDP1 + 5120 + c0 + 8 * q); }
        { float hv[16], t1[8], t2[8], ov[16]; float ss = 0.f;
#pragma unroll
          for (int q = 0; q < 2; ++q) { unpack8(of[q], t1); unpack8(ob[q], t2); unpack8(og[q], ov + 8 * q);
#pragma unroll
              for (int e = 0; e < 8; ++e) { hv[8 * q + e] = t1[e] + t2[e]; ss += hv[8 * q + e] * hv[8 * q + e]; } }
          ss = sum8(ss);
          const float r = __builtin_amdgcn_rsqf(ss * (1.f / 128.f) + EPS);
#pragma unroll
          for (int e = 0; e < 16; ++e) hv[e] = hv[e] * r * hg[e] * siluf_(ov[e]);
          *(u32x4*)(Y + (size_t)row * DM + c0) = pack8(hv); *(u32x4*)(Y + (size_t)row * DM + c0 + 8) = pack8(hv + 8); }
        { float yv[16], t1[8], t2[8], t3[8], t4[8]; float ss = 0.f;
#pragma unroll
          for (int q = 0; q < 2; ++q) { unpack8(yf[q], t1); unpack8(yb[q], t2); unpack8(xv[q], t3); unpack8(zv[q], t4);
#pragma unroll
              for (int e = 0; e < 8; ++e) { const float y = (t1[e] + t2[e] + ds * t3[e]) * siluf_(t4[e]); yv[8 * q + e] = y; ss += y * y; } }
          ss = sum8(ss); ss += __shfl_xor(ss, 8); ss += __shfl_xor(ss, 16);
          const float r = __builtin_amdgcn_rsqf(ss * (1.f / 512.f) + EPS);
#pragma unroll
          for (int e = 0; e < 16; ++e) yv[e] = yv[e] * r * sg[e];
          *(u32x4*)(Y + (size_t)row * DM + 1024 + c0) = pack8(yv); *(u32x4*)(Y + (size_t)row * DM + 1024 + c0 + 8) = pack8(yv + 8); }
    }
}

#define XB_TMO      128
#define XB_XCNT(j)  (256  + 64 * (j))
#define XB_XSUB(j)  (1280 + 64 * (j))
#define XB_XGEN(j)  (2304 + 64 * (j))
#define XB_TOP      3328
#define XB_TOPGEN   3392
#define XCD_BAR_WORDS 3456
#define XB_SPIN_CAP (1u << 18)

__device__ __forceinline__ unsigned xb_ld(unsigned* p)              { return __hip_atomic_load(p, __ATOMIC_RELAXED, __HIP_MEMORY_SCOPE_AGENT); }
__device__ __forceinline__ unsigned xb_add(unsigned* p, unsigned v) { return __hip_atomic_fetch_add(p, v, __ATOMIC_RELAXED, __HIP_MEMORY_SCOPE_AGENT); }
__device__ __forceinline__ unsigned xb_xcc_id() { return (unsigned)__builtin_amdgcn_s_getreg((3 << 11) | 20) & 0xFu; }
#define XB_SPIN(cond, bar) do { unsigned _sp = 0; while (cond) { __builtin_amdgcn_s_sleep(1); \
    if ((++_sp & 255u) == 0u) { if (xb_ld(&(bar)[XB_TMO])) break; if (_sp > XB_SPIN_CAP) { atomicAdd(&(bar)[XB_TMO], 1u); break; } } } } while (0)

struct XcdBarrier {
    unsigned* bar; unsigned x;
    volatile LAS unsigned* st;
};

__device__ __forceinline__ XcdBarrier xcd_barrier_post(unsigned* bar, volatile LAS unsigned* st) {
    XcdBarrier b; b.bar = bar; b.x = xb_xcc_id(); b.st = st;
    if (threadIdx.x == 0) (void)xb_add(&bar[XB_XCNT(b.x)], 1u);
    return b;
}
__device__ __forceinline__ void xcd_barrier_complete(unsigned* bar, unsigned x, unsigned& nloc, unsigned& nx) {
    const unsigned G = gridDim.x * gridDim.y * gridDim.z;
    unsigned sum, cnt, mine, sp = 0u;
    for (;;) {
        sum = 0u; cnt = 0u; mine = 0u;
#pragma unroll
        for (unsigned j = 0; j < 16; ++j) { const unsigned c = xb_ld(&bar[XB_XCNT(j)]); sum += c; cnt += (c > 0u) ? 1u : 0u; mine = (j == x) ? c : mine; }
        if (sum == G) break;
        __builtin_amdgcn_s_sleep(1);
        if ((++sp & 255u) == 0u) { if (xb_ld(&bar[XB_TMO])) break; if (sp > XB_SPIN_CAP) { atomicAdd(&bar[XB_TMO], 1u); break; } }
    }
    nloc = mine > 0u ? mine : 1u; nx = cnt > 0u ? cnt : 1u;
}

__device__ __forceinline__ void xcd_barrier(const XcdBarrier& b) {
    asm volatile("s_waitcnt vmcnt(0)" ::: "memory");
    __syncthreads();
    if (threadIdx.x == 0) {
        unsigned* bar = b.bar;
        __builtin_amdgcn_s_waitcnt(0);
        unsigned nloc = b.st[0], nx = b.st[1];
        if (nloc == 0u) { xcd_barrier_complete(bar, b.x, nloc, nx); b.st[0] = nloc; b.st[1] = nx; }
        const unsigned old = xb_add(&bar[XB_XSUB(b.x)], 1u);
        const unsigned gen = old / nloc;
        if (old + 1u == (gen + 1u) * nloc) {
            __builtin_amdgcn_fence(__ATOMIC_RELEASE, "agent");
            asm volatile("s_waitcnt vmcnt(0)" ::: "memory");
            const unsigned og = xb_add(&bar[XB_TOP], 1u);
            const unsigned tg = og / nx;
            if (og + 1u == (tg + 1u) * nx) xb_add(&bar[XB_TOPGEN], 1u);
            else XB_SPIN(xb_ld(&bar[XB_TOPGEN]) == tg, bar);
            __builtin_amdgcn_fence(__ATOMIC_ACQUIRE, "agent");
            xb_add(&bar[XB_XGEN(b.x)], 1u);
            asm volatile("s_waitcnt vmcnt(0)" ::: "memory");
        } else {
            XB_SPIN(xb_ld(&bar[XB_XGEN(b.x)]) == gen, bar);
            __builtin_amdgcn_fence(__ATOMIC_ACQUIRE, "agent");
            asm volatile("s_waitcnt vmcnt(0)" ::: "memory");
        }
    }
    __syncthreads();
}

#ifndef CHUNK_SSD
#define CHUNK_SSD 1
#endif
#ifndef CHUNK_HG
#define CHUNK_HG 1
#endif
#ifndef CHUNK_ML
#define CHUNK_ML 1
#endif
#if CHUNK_SSD
#define SSD_CHAIN ssd_chain2
#else
#define SSD_CHAIN ssd_chain
#endif
#if CHUNK_HG
#define HGRN_CHAIN hgrn_chain2
#else
#define HGRN_CHAIN hgrn_chain
#endif
#if CHUNK_ML
#define MLSTM_CHAIN mlstm_chain2
#else
#define MLSTM_CHAIN mlstm_chain
#endif
#ifndef PROBE_ML
#define PROBE_ML 1
#endif
#ifndef PROBE_NA
#define PROBE_NA 1
#endif
#ifndef PROBE_SYNCS
#define PROBE_SYNCS 0
#endif
#ifndef PROBE_CONV_IN_P12
#define PROBE_CONV_IN_P12 1
#endif
#ifndef PROBE_MASK
#define PROBE_MASK 0
#endif
#define REP(k) _Pragma("unroll 1") for (int rep_ = 0; rep_ < ((((PROBE_MASK) >> (k)) & 1) ? 2 : 1); ++rep_)
constexpr int NPHASE = 18;
struct SkipVOrder : pg8::StaticOrder {
    __device__ bool next(int i, pg8::Unit& u) const { const bool ok = pg8::StaticOrder::next(i, u); if (ok && u.pn >= 8) u.pn += 4; return ok; }
};
struct SplitKOrder {
    int G, c;
    __device__ bool next(int i, pg8::Unit& u) const { const int L = i * G + c; if (L >= 128) return false; u.ks = L & 3; u.pn = (L >> 2) & 7; u.pm = L >> 5; return true; }
    __device__ __forceinline__ void a_ready(const pg8::Unit&) const {}
    __device__ __forceinline__ void done(const pg8::Unit&) const {}
};
struct EpiPart {
    static constexpr bool PERM = false, AFTER_DRAIN = false;
    float* part;
    __device__ __forceinline__ void operator()(const f32x4 (&acc)[2][2][4][2], const pg8::Unit& u, int wr, int wc, int fr, int fq) const {
        float* base = part + (size_t)u.ks * MCTX * DM + (size_t)(u.pm * 256 + wr * 64 + fr) * DM + u.pn * 256 + wc * 32 + 4 * fq;
#pragma unroll
        for (int ai = 0; ai < 2; ++ai)
#pragma unroll
            for (int m = 0; m < 4; ++m)
#pragma unroll
                for (int bj = 0; bj < 2; ++bj)
#pragma unroll
                    for (int n = 0; n < 2; ++n) *(f32x4*)(base + (size_t)(ai * 128 + m * 16) * DM + bj * 128 + n * 16) = acc[ai][bj][m][n];
    }
};
struct Args { const float* in[31]; float* out; unsigned char* ws; int ph_lo, ph_hi; };

__global__ void __launch_bounds__(NTHR, 2) fwd_kernel(Args a) {
    extern __shared__ __attribute__((aligned(16))) unsigned char lds_raw[];
    LAS unsigned char* lds = (LAS unsigned char*)lds_raw;
    cg::grid_group grid = cg::this_grid();
    unsigned char* ws = a.ws;
    float* MOD = (float*)(ws + WS_MOD);
    bf16* WIN = (bf16*)(ws + WS_WIN); bf16* WOUT = (bf16*)(ws + WS_WOUT); bf16* W13 = (bf16*)(ws + WS_W13); bf16* W2 = (bf16*)(ws + WS_W2);
    bf16* A = (bf16*)(ws + WS_A); bf16* P = (bf16*)(ws + WS_P); bf16* HB = (bf16*)(ws + WS_P); float* G = (float*)(ws + WS_G); bf16* Y = (bf16*)(ws + WS_Y);
    bf16* VT = (bf16*)(ws + WS_VT); bf16* XBC = (bf16*)(ws + WS_VT); bf16* DIRA = (bf16*)(ws + WS_A); bf16* DIRB = (bf16*)(ws + WS_DIRB); float* XC = (float*)(ws + WS_XC); float* PART = (float*)(ws + WS_PART); bf16* XB = (bf16*)(ws + WS_XB);
    const int lo = a.ph_lo, hi = a.ph_hi;
    volatile LAS unsigned* bst = (volatile LAS unsigned*)(lds + LDS_BYTES - 16);
    if (threadIdx.x < 4) bst[threadIdx.x] = 0u;
    __syncthreads();
    XcdBarrier xbar = xcd_barrier_post((unsigned*)(ws + WS_BAR), bst);
    if (lo < 0) grid.sync();
    const int wave = threadIdx.x >> 6, lane = threadIdx.x & 63;
    const int GSZ = gridDim.x, bid = blockIdx.x;
#define IN(k) (lo <= (k) && (k) < hi)
#define SEAM(k) do { if (IN(k) && IN((k) + 1)) xcd_barrier(xbar); } while (0)

    if (IN(0)) REP(0) {
        mod_gemv(lds, a.in[1], a.in[3], a.in[5], a.in[6], a.in[17], a.in[18], MOD);
        convert_weights(lds, ws, a.in[7], EVEN_IN, a.in[13], a.in[14], a.in[15], a.in[16], 3, bid, GSZ);
    }
    SEAM(0);
    if (IN(1)) REP(1) phase_modulate<false>(a.in[0], a.in[2], MOD, 0, 1, A, MTOT);
    SEAM(1);
    if (IN(2)) REP(2) {
        { pg8::Gemm g{A, WIN, MTOT, 6400, DM}; SkipVOrder S; S.init(MTOT, 6400 - 1024, GSZ, bid); EpiProj E{P, LDP0, 24, G, 16};
          pg8::gemm_phase<EpiProj, SkipVOrder, true, true>(lds, g, S, E); }
        { pg8::Gemm g{WIN + (size_t)2048 * DM, A, 1024, MTOT, DM}; pg8::StaticOrder S; S.init(1024, MTOT, GSZ, GSZ - 1 - bid); EpiBf E{VT, MTOT};
          pg8::gemm_phase<EpiBf, pg8::StaticOrder, true, true>(lds, g, S, E); }
        if (GSZ == 256) { if (bid >= 148 && bid < 240) convert_weights(lds, ws, a.in[7], EVEN_IN, a.in[13], a.in[14], a.in[15], a.in[16], 4, bid - 148, 92); }
        else convert_weights(lds, ws, a.in[7], EVEN_IN, a.in[13], a.in[14], a.in[15], a.in[16], 4, bid, GSZ);
    }
    SEAM(2);
    if (IN(3)) REP(3) {
        const int NCH = GSZ >= 256 ? 128 : GSZ / 2;
        unsigned* qctr = (unsigned*)(ws + WS_BAR) + 3584;
#define NA_QUEUE() for (;;) { unsigned wt = 0; if (lane == 0) wt = __hip_atomic_fetch_add(qctr, 1u, __ATOMIC_RELAXED, __HIP_MEMORY_SCOPE_AGENT); \
            wt = (unsigned)__builtin_amdgcn_readfirstlane((int)wt); if (wt >= 8192u + 512u) break; na_tile2((int)wt, P, VT, a.in[8], a.in[9], a.in[10], Y, lane); }
        if (bid < NCH) { for (int c = bid; c < 128; c += NCH) MLSTM_CHAIN(lds, c, P, G, a.in[11], DIRA); NA_QUEUE(); }
        else { NA_QUEUE(); }
    }
    SEAM(3);
    if (IN(4)) REP(4) phase_post0(DIRA, P, a.in[12], Y);
    SEAM(4);
    if (IN(5)) REP(5) {
        { pg8::Gemm g{Y, WOUT, MLAT, DM, DM}; pg8::StaticOrder S; S.init(MLAT, DM, GSZ, bid); EpiRes<false, true> E{a.in[0], XB, MOD + 2 * DM};
          pg8::gemm_phase<EpiRes<false, true>, pg8::StaticOrder, true, true>(lds, g, S, E); }
        { pg8::Gemm g{Y + (size_t)MLAT * DM, WOUT, MCTX, DM, DM / 4, DM}; SplitKOrder S{GSZ, bid}; EpiPart E{PART};
          pg8::gemm_phase<EpiPart, SplitKOrder, true, true>(lds, g, S, E); }
        if (GSZ == 256) { if (bid >= 128) convert_weights(lds, ws, a.in[7], EVEN_IN, a.in[13], a.in[14], a.in[15], a.in[16], 8, bid - 128, 128); }
        else convert_weights(lds, ws, a.in[7], EVEN_IN, a.in[13], a.in[14], a.in[15], a.in[16], 8, bid, GSZ); }
    SEAM(5);
    if (IN(6)) REP(6) phase_modulate<true>(XB, XC, MOD, 3, 4, A, MTOT, PART, a.in[2], MOD + 4 * NMODC + 2 * DM, XC);
    SEAM(6);
    if (IN(7)) REP(7) { pg8::Gemm g{A, W13, MTOT, 2 * FFH, DM}; pg8::StaticOrder S; S.init(MTOT, 2 * FFH, GSZ, bid); EpiSwiglu E{HB, FFH};
        pg8::gemm_phase<EpiSwiglu, pg8::StaticOrder, true, true>(lds, g, S, E);
        if (GSZ == 256) { if (bid >= 176) convert_weights(lds, ws, a.in[7], EVEN_IN, a.in[13], a.in[14], a.in[15], a.in[16], 16, bid - 176, 80); }
        else convert_weights(lds, ws, a.in[7], EVEN_IN, a.in[13], a.in[14], a.in[15], a.in[16], 16, bid, GSZ); }
    SEAM(7);
    if (IN(8)) REP(8) {
        { pg8::Gemm g{HB, W2, MLAT, DM, FFH}; pg8::StaticOrder S; S.init(MLAT, DM, GSZ, bid); EpiRes<true, true> E{XB, XB, MOD + 5 * DM};
          pg8::gemm_phase<EpiRes<true, true>, pg8::StaticOrder, true, true>(lds, g, S, E); }
        if (bid < 128 || GSZ < 256) { pg8::Gemm g{HB + (size_t)MLAT * FFH, W2, MCTX, DM, FFH / 4, FFH}; SplitKOrder S{GSZ, bid}; EpiPart E{PART};
          pg8::gemm_phase<EpiPart, SplitKOrder, true, true>(lds, g, S, E); }
        if (GSZ < 256) convert_weights(lds, ws, a.in[19], ODD_IN, a.in[27], a.in[28], a.in[29], a.in[30], 1, bid, GSZ);
        else if (bid >= 128) convert_weights(lds, ws, a.in[19], ODD_IN, a.in[27], a.in[28], a.in[29], a.in[30], 1, bid - 128, GSZ - 128); }
    SEAM(8);
    if (IN(9)) REP(9) {
        phase_modulate<true>(XB, XC, MOD + 5 * NMODC, 0, 1, A, MTOT, PART, XC, MOD + 4 * NMODC + 5 * DM, XC);
        if (!PROBE_CONV_IN_P12) convert_weights(lds, ws, a.in[19], ODD_IN, a.in[27], a.in[28], a.in[29], a.in[30], 30, bid, GSZ);
    }
    SEAM(9);
    if (IN(10)) REP(10) { pg8::Gemm g{A, WIN, MTOT, 7936, DM}; pg8::StaticOrder S; S.init(MTOT, 7936, GSZ, bid); EpiProj E{P, LDP1, 30, G, 32};
        pg8::gemm_phase<EpiProj, pg8::StaticOrder, true, true>(lds, g, S, E); }
    SEAM(10);
    if (IN(11)) REP(11) phase_conv(P, a.in[21], a.in[22], XBC);
    SEAM(11);
    if (IN(12)) REP(12) {
        const int NCH = GSZ >= 256 ? 128 : GSZ / 2;
        if (bid < NCH) { for (int c = bid; c < 128; c += NCH) HGRN_CHAIN(lds, c, P, a.in[4], DIRA); }
        else { for (int c = bid - NCH; c < 128; c += GSZ - NCH) SSD_CHAIN(lds, c, XBC, G, a.in[23], a.in[24], DIRB);
            __syncthreads();
            if (PROBE_CONV_IN_P12) convert_weights(lds, ws, a.in[19], ODD_IN, a.in[27], a.in[28], a.in[29], a.in[30], 30, bid - NCH, GSZ - NCH); }
    }
    SEAM(12);
    if (IN(13)) REP(13) phase_post1(DIRA, DIRB, P, XBC, a.in[20], a.in[25], a.in[26], Y);
    SEAM(13);
    if (IN(14)) REP(14) { pg8::Gemm g{Y, WOUT, MLAT, DM, DM}; pg8::StaticOrder S; S.init(MLAT, DM, GSZ, bid); EpiRes<true, true> E{XB, XB, MOD + 5 * NMODC + 2 * DM};
        pg8::gemm_phase<EpiRes<true, true>, pg8::StaticOrder, true, true>(lds, g, S, E); }
    SEAM(14);
    if (IN(15)) REP(15) phase_modulate<true>(XB, XC, MOD + 5 * NMODC, 3, 4, A, MLAT);
    SEAM(15);
    if (IN(16)) REP(16) { pg8::Gemm g{A, W13, MLAT, 2 * FFH, DM}; pg8::StaticOrder S; S.init(MLAT, 2 * FFH, GSZ, bid); EpiSwiglu E{HB, FFH};
        pg8::gemm_phase<EpiSwiglu, pg8::StaticOrder, true, true>(lds, g, S, E); }
    SEAM(16);
    if (IN(17)) REP(17) { pg8::Gemm g{HB, W2, MLAT, DM, FFH}; pg8::StaticOrder S; S.init(MLAT, DM, GSZ, bid); EpiRes<true, false> E{XB, a.out, MOD + 5 * NMODC + 5 * DM};
        pg8::gemm_phase<EpiRes<true, false>, pg8::StaticOrder, true, true>(lds, g, S, E); }
#undef IN
#undef SEAM
}

#ifndef MK_N_LAUNCHES
#define MK_N_LAUNCHES 1
#endif
extern "C" void kernel_launch(void* const* d_in, const int* in_sizes, int n_in, void* d_out, int out_size, void* d_ws, size_t ws_size, hipStream_t stream) {
    static int grid = 0;
    if (grid == 0) {
        if (n_in != 31 || out_size != MLAT * DM || ws_size < WS_END) { fprintf(stderr, "kernel_launch: unexpected shapes: n_in %d out %d ws %zu (need %zu)\n", n_in, out_size, ws_size, (size_t)WS_END); grid = -1; return; }
        int dev = 0, cus = 0, per_cu = 0;
        hipGetDevice(&dev); hipDeviceGetAttribute(&cus, hipDeviceAttributeMultiprocessorCount, dev);
        if (hipFuncSetAttribute((const void*)fwd_kernel, hipFuncAttributeMaxDynamicSharedMemorySize, LDS_BYTES) != hipSuccess) { fprintf(stderr, "kernel_launch: hipFuncSetAttribute failed\n"); grid = -1; return; }
        if (hipOccupancyMaxActiveBlocksPerMultiprocessor(&per_cu, (const void*)fwd_kernel, NTHR, LDS_BYTES) != hipSuccess || per_cu < 1) { fprintf(stderr, "kernel_launch: occupancy query says %d\n", per_cu); per_cu = 1; }
        (void)hipGetLastError();
        grid = cus * 1;
        if (grid > 256) grid = 256;
    }
    if (grid < 0) return;
    if (hipMemsetAsync((char*)d_ws + WS_BAR, 0, BAR_BYTES, stream) != hipSuccess) { fprintf(stderr, "kernel_launch: memset failed\n"); return; }
    Args a{};
    for (int i = 0; i < 31; ++i) a.in[i] = (const float*)d_in[i];
    a.out = (float*)d_out; a.ws = (unsigned char*)d_ws;
#if MK_N_LAUNCHES == 1
    a.ph_lo = 0; a.ph_hi = NPHASE;
    void* args[] = {&a};
    hipError_t e = hipLaunchCooperativeKernel((const void*)fwd_kernel, dim3(grid), dim3(NTHR), args, LDS_BYTES, stream);
    if (e != hipSuccess) fprintf(stderr, "kernel_launch: cooperative launch failed: %s (grid %d)\n", hipGetErrorString(e), grid);
#else
    for (int p = 0; p < NPHASE; ++p) { a.ph_lo = p; a.ph_hi = p + 1; hipLaunchKernelGGL(fwd_kernel, dim3(grid), dim3(NTHR), LDS_BYTES, stream, a); }
#endif
}
```
